# Optimizing an MI355X kernel written in HIP

```python
import jax, jax.numpy as jnp
from jax import lax
import numpy as np

D_MODEL = 1024
BATCH = 2
SEQ = 8192
DEPTH = 4

GRID_W = 64
D_MIX = 2 * D_MODEL
POOL_WIDTH = D_MIX // 4
LRU_WIDTH = 3 * D_MIX // 8
ATTN_WIDTH = 3 * D_MIX // 8
POOL_WINDOWS = (2, 4, 8, 16)
POOL_GROUPS = len(POOL_WINDOWS)
POOL_GROUP_DIM = POOL_WIDTH // POOL_GROUPS
LRU_BLOCKS = 6
LRU_BLOCK_DIM = LRU_WIDTH // LRU_BLOCKS
LRU_C = 8.0
CONV_WIDTH = 4
CONV_PAD_LEFT = 1
HEAD_DIM = 128
N_Q_HEADS = ATTN_WIDTH // HEAD_DIM
N_KV_HEADS = 2
GQA_GROUP = N_Q_HEADS // N_KV_HEADS
KV_WIDTH = N_KV_HEADS * HEAD_DIM
ROPE_AXIS_DIM = HEAD_DIM // 2
ROPE_BASE = 10000.0
Q_BLOCK = 128
EPS = 1e-6
IN_SIZES = (POOL_WIDTH, POOL_WIDTH, LRU_WIDTH, LRU_WIDTH, ATTN_WIDTH, KV_WIDTH, KV_WIDTH, ATTN_WIDTH)
D_IN = sum(IN_SIZES)

kernel_name = "hymba_pool_rglru_axialgqa_encoder"


def rmsnorm(x, g):
    xf = x.astype(jnp.float32)
    y = xf * lax.rsqrt(jnp.mean(xf * xf, axis=-1, keepdims=True) + EPS)
    return (y * g.astype(jnp.float32)).astype(x.dtype)


def pool_mixer(u, w_pool, scale):
    B, L, _ = u.shape
    uf = u.astype(jnp.float32)
    cs = jnp.concatenate([jnp.zeros((B, 1, POOL_WIDTH), jnp.float32), jnp.cumsum(uf, axis=1)], axis=1)
    t = jnp.arange(L)
    means = []
    for g, w in enumerate(POOL_WINDOWS):
        half = w // 2
        lo = jnp.clip(t - half, 0, L)
        hi = jnp.clip(t + half, 0, L)
        csg = cs[..., g * POOL_GROUP_DIM:(g + 1) * POOL_GROUP_DIM]
        cnt = (hi - lo).astype(jnp.float32)[None, :, None]
        means.append((csg[:, hi] - csg[:, lo]) / cnt)
    pooled = jnp.stack(means, axis=2) - uf.reshape(B, L, POOL_GROUPS, POOL_GROUP_DIM)
    mixed = jnp.einsum('blgc,gcd->blgd', pooled.astype(u.dtype), w_pool)
    return mixed.reshape(B, L, POOL_WIDTH) * scale


def short_conv(u, w, b):
    L = u.shape[1]
    up = jnp.pad(u, ((0, 0), (CONV_PAD_LEFT, CONV_WIDTH - 1 - CONV_PAD_LEFT), (0, 0)))
    y = b
    for k in range(CONV_WIDTH):
        y = y + up[:, k:k + L] * w[k]
    return y


def _lin_combine(earlier, later):
    a1, b1 = earlier
    a2, b2 = later
    return (a1 * a2, a2 * b1 + b2)


def rg_lru_bidir(u, conv_w, conv_b, w_r, b_r, w_i, b_i, lam):
    B, L, _ = u.shape
    xc = short_conv(u, conv_w, conv_b)
    xb = xc.reshape(B, L, LRU_BLOCKS, LRU_BLOCK_DIM)
    xf = xc.astype(jnp.float32)
    hs = []
    for d, rev in enumerate((False, True)):
        r = jax.nn.sigmoid((jnp.einsum('blhc,hcd->blhd', xb, w_r[d]).reshape(B, L, LRU_WIDTH) + b_r[d]).astype(jnp.float32))
        i = jax.nn.sigmoid((jnp.einsum('blhc,hcd->blhd', xb, w_i[d]).reshape(B, L, LRU_WIDTH) + b_i[d]).astype(jnp.float32))
        log_a = LRU_C * r * jax.nn.log_sigmoid(lam[d].astype(jnp.float32))
        a = jnp.exp(log_a)
        inp = jnp.sqrt(-jnp.expm1(2.0 * log_a)) * (i * xf)
        _, h = lax.associative_scan(_lin_combine, (a, inp), reverse=rev, axis=1)
        hs.append(h)
    return (hs[0] + hs[1]).astype(u.dtype)


def axial_rope_tables(L):
    rows = L // GRID_W
    row = jnp.repeat(jnp.arange(rows), GRID_W).astype(jnp.float32)
    col = jnp.tile(jnp.arange(GRID_W), rows).astype(jnp.float32)
    inv = ROPE_BASE ** (-jnp.arange(0, ROPE_AXIS_DIM, 2, dtype=jnp.float32) / ROPE_AXIS_DIM)
    ang = jnp.stack([row[:, None] * inv, col[:, None] * inv], axis=1)
    return jnp.cos(ang), jnp.sin(ang)


def apply_axial_rope(x, cos, sin):
    B, L, H, D = x.shape
    xs = x.astype(jnp.float32).reshape(B, L, H, 2, 2, ROPE_AXIS_DIM // 2)
    x1, x2 = xs[..., 0, :], xs[..., 1, :]
    c, s = cos[:, None], sin[:, None]
    out = jnp.stack([x1 * c - x2 * s, x2 * c + x1 * s], axis=-2)
    return out.reshape(B, L, H, D).astype(x.dtype)


def block_attention(q, k, v):
    B, L = q.shape[0], q.shape[1]
    nb = L // Q_BLOCK
    qb = q.reshape(B, nb, Q_BLOCK, N_KV_HEADS, GQA_GROUP, HEAD_DIM).transpose(1, 0, 2, 3, 4, 5)
    scale = HEAD_DIM ** -0.5

    def one_block(qblk):
        s = jnp.einsum('bqkgd,bskd->bkgqs', qblk, k, preferred_element_type=jnp.float32) * scale
        p = jax.nn.softmax(s, axis=-1)
        return jnp.einsum('bkgqs,bskd->bqkgd', p.astype(v.dtype), v)

    o = lax.map(one_block, qb)
    return o.transpose(1, 0, 2, 3, 4, 5).reshape(B, L, ATTN_WIDTH)


def setup_inputs(seed: int = 0) -> dict:
    key = jax.random.key(seed)
    ks = jax.random.split(key, 16)
    f32 = jnp.float32
    nrm = lambda k, shape, s: jax.random.normal(k, shape, f32) * s
    u = jax.random.uniform(ks[11], (DEPTH, 2, LRU_WIDTH), f32, 0.9, 0.999)
    sg = u ** (1.0 / LRU_C)
    lru_lam = jnp.log(sg) - jnp.log1p(-sg)
    return {
        "x": nrm(ks[0], (BATCH, SEQ, D_MODEL), 1.0),
        "norm_g": 1.0 + nrm(ks[1], (DEPTH, D_MODEL), 0.02),
        "w_in": nrm(ks[2], (DEPTH, D_MODEL, D_IN), D_MODEL ** -0.5),
        "pool_w": nrm(ks[3], (DEPTH, POOL_GROUPS, POOL_GROUP_DIM, POOL_GROUP_DIM), POOL_GROUP_DIM ** -0.5),
        "pool_scale": 1.0 + nrm(ks[4], (DEPTH, POOL_WIDTH), 0.02),
        "conv_w": nrm(ks[5], (DEPTH, CONV_WIDTH, LRU_WIDTH), CONV_WIDTH ** -0.5),
        "conv_b": nrm(ks[6], (DEPTH, LRU_WIDTH), 0.01),
        "lru_wr": nrm(ks[7], (DEPTH, 2, LRU_BLOCKS, LRU_BLOCK_DIM, LRU_BLOCK_DIM), LRU_BLOCK_DIM ** -0.5),
        "lru_br": nrm(ks[8], (DEPTH, 2, LRU_WIDTH), 0.01),
        "lru_wi": nrm(ks[9], (DEPTH, 2, LRU_BLOCKS, LRU_BLOCK_DIM, LRU_BLOCK_DIM), LRU_BLOCK_DIM ** -0.5),
        "lru_bi": nrm(ks[10], (DEPTH, 2, LRU_WIDTH), 0.01),
        "lru_lam": lru_lam,
        "q_norm": 1.0 + nrm(ks[12], (DEPTH, HEAD_DIM), 0.02),
        "k_norm": 1.0 + nrm(ks[13], (DEPTH, HEAD_DIM), 0.02),
        "w_out": nrm(ks[14], (DEPTH, D_MIX, D_MODEL), D_MIX ** -0.5),
    }


def reference(x, norm_g, w_in, pool_w, pool_scale, conv_w, conv_b, lru_wr, lru_br, lru_wi, lru_bi,
              lru_lam, q_norm, k_norm, w_out):
    B, L, _ = x.shape
    cos, sin = axial_rope_tables(L)
    splits = []
    acc = 0
    for s in IN_SIZES[:-1]:
        acc += s
        splits.append(acc)
    for l in range(DEPTH):
        h = rmsnorm(x, norm_g[l])
        z = jnp.einsum('bld,de->ble', h, w_in[l])
        u_pool, g_pool, u_lru, g_lru, q, k, v, g_attn = jnp.split(z, splits, axis=-1)

        y_pool = pool_mixer(u_pool, pool_w[l], pool_scale[l]) * jax.nn.silu(g_pool)

        y_lru = rg_lru_bidir(u_lru, conv_w[l], conv_b[l], lru_wr[l], lru_br[l], lru_wi[l], lru_bi[l],
                             lru_lam[l]) * jax.nn.silu(g_lru)

        q = rmsnorm(q.reshape(B, L, N_Q_HEADS, HEAD_DIM), q_norm[l])
        k = rmsnorm(k.reshape(B, L, N_KV_HEADS, HEAD_DIM), k_norm[l])
        v = v.reshape(B, L, N_KV_HEADS, HEAD_DIM)
        q = apply_axial_rope(q, cos, sin)
        k = apply_axial_rope(k, cos, sin)
        y_attn = block_attention(q, k, v) * jax.nn.silu(g_attn)

        y = jnp.concatenate([y_pool, y_lru, y_attn], axis=-1)
        x = x + jnp.einsum('ble,ed->bld', y, w_out[l])
    return x
```

```cpp
#include <hip/hip_runtime.h>
#include <hip/hip_cooperative_groups.h>
#include <cstdio>
#include <cstdint>
#include <cmath>
namespace cg = cooperative_groups;

namespace pg8 {
#define PG8_LAS __attribute__((address_space(3)))
typedef unsigned short bf16_t;
typedef short bf16x8 __attribute__((ext_vector_type(8)));
typedef float f32x4 __attribute__((ext_vector_type(4)));
typedef unsigned u32x4 __attribute__((ext_vector_type(4)));
constexpr int BM = 256, BK = 64, HALF = 128, HTB = HALF * BK * 2  , STAGE_BYTES = 8 * HTB, NXCD = 8, WGM = 8;

__host__ __device__ __forceinline__ int lds_byte(int r, int c) { const int st = (r >> 4) * 2 + (c >> 5), rr = r & 15, cc = c & 31, ob = rr * 64 + cc * 2; return st * 1024 + (ob ^ (((ob >> 9) & 1) << 5)); }
__host__ __device__ __forceinline__ void stage_rc(int b, int& R, int& C) { const int st = b / 1024, sb = b % 1024, swz = sb ^ (((sb >> 9) & 1) << 5); R = (st >> 1) * 16 + swz / 64; C = (st & 1) * 32 + (swz % 64) / 2; }
__host__ __device__ __forceinline__ int perm32(int rho) { const int n = rho >> 4, i = rho & 15; return 8 * (i >> 2) + 4 * n + (i & 3); }

struct Unit { int pm, pn; };
struct Gemm { const bf16_t* A; const bf16_t* Bt; int M, N, K; };

struct StaticOrder {
    int nM, nN, nwg, G, c;
    __host__ __device__ void init(int M, int N, int G_, int c_) { nM = M / BM; nN = N / BM; nwg = nM * nN; G = G_; c = c_; }
    __host__ __device__ bool next(int i, Unit& u) const {
        const long L = (long)i * G + c; if (L >= nwg) return false;
        int wgid = (int)L; { const int q = nwg / NXCD, r = nwg % NXCD, xcd = wgid % NXCD, off = wgid / NXCD; wgid = (xcd < r ? xcd * (q + 1) : r * (q + 1) + (xcd - r) * q) + off; }
        const int nig = WGM * nN, gid = wgid / nig, fm = gid * WGM, gsz = (nM - fm) < WGM ? (nM - fm) : WGM;
        u.pm = fm + ((wgid % nig) % gsz); u.pn = (wgid % nig) / gsz; return true;
    }
    __device__ __forceinline__ void a_ready(const Unit&) const {}
    __device__ __forceinline__ void done(const Unit&) const {}
};

__device__ __forceinline__ unsigned cvt_pk_bf16(float lo, float hi) { unsigned r; asm volatile("v_cvt_pk_bf16_f32 %0, %1, %2" : "=v"(r) : "v"(lo), "v"(hi)); return r; }

struct EpiZ {
    static constexpr bool PERM = true, AFTER_DRAIN = false;
    bf16_t* Z; const PG8_LAS float* rsl; const PG8_LAS int* pml; int ldz;
    __device__ __forceinline__ void operator()(const f32x4 (&acc)[2][2][4][2], const Unit& u, int wr, int wc, int fr, int fq) const {
        const int row0 = u.pm * BM + wr * 64 + fr, col0 = u.pn * BM + wc * 32 + 8 * fq;
        int slot = 0;
#pragma unroll
        for (int i = 1; i < 8; ++i) slot = (pml[i] == u.pm) ? i : slot;
        const PG8_LAS float* rp = rsl + slot * 256 + wr * 64 + fr;
#pragma unroll
        for (int ai = 0; ai < 2; ++ai)
#pragma unroll
            for (int m = 0; m < 4; ++m) { const int row = row0 + ai * HALF + m * 16;
                const float rs = rp[ai * HALF + m * 16];
                bf16_t* rowp = Z + (size_t)row * ldz + col0;
#pragma unroll
                for (int bj = 0; bj < 2; ++bj) { const f32x4 v0 = acc[ai][bj][m][0] * rs, v1 = acc[ai][bj][m][1] * rs;
                    u32x4 w; w.x = cvt_pk_bf16(v0[0], v0[1]); w.y = cvt_pk_bf16(v0[2], v0[3]); w.z = cvt_pk_bf16(v1[0], v1[1]); w.w = cvt_pk_bf16(v1[2], v1[3]);
                    *(u32x4*)(rowp + bj * HALF) = w; } }
    }
};
struct EpiRes {
    static constexpr bool PERM = true, AFTER_DRAIN = false;
    const float* xin; float* out; bf16_t* XB; float* ssq;
    __device__ __forceinline__ void operator()(const f32x4 (&acc)[2][2][4][2], const Unit& u, int wr, int wc, int fr, int fq) const {
        const int row0 = u.pm * BM + wr * 64 + fr, col0 = u.pn * BM + wc * 32 + 8 * fq;
#pragma unroll
        for (int ai = 0; ai < 2; ++ai) {
            f32x4 xa[4][2][2];
#pragma unroll
            for (int m = 0; m < 4; ++m)
#pragma unroll
                for (int bj = 0; bj < 2; ++bj) { const size_t off = (size_t)(row0 + ai * HALF + m * 16) * 1024 + col0 + bj * HALF;
                    xa[m][bj][0] = *(const f32x4*)(xin + off); xa[m][bj][1] = *(const f32x4*)(xin + off + 4); }
#pragma unroll
            for (int m = 0; m < 4; ++m) { const int row = row0 + ai * HALF + m * 16; float q = 0.f;
#pragma unroll
                for (int bj = 0; bj < 2; ++bj) { const size_t off = (size_t)row * 1024 + col0 + bj * HALF;
                    const f32x4 v0 = acc[ai][bj][m][0] + xa[m][bj][0], v1 = acc[ai][bj][m][1] + xa[m][bj][1];
                    *(f32x4*)(out + off) = v0; *(f32x4*)(out + off + 4) = v1;
                    q += (v0[0] * v0[0] + v0[1] * v0[1]) + (v0[2] * v0[2] + v0[3] * v0[3]) + (v1[0] * v1[0] + v1[1] * v1[1]) + (v1[2] * v1[2] + v1[3] * v1[3]);
                    u32x4 w; w.x = cvt_pk_bf16(v0[0], v0[1]); w.y = cvt_pk_bf16(v0[2], v0[3]); w.z = cvt_pk_bf16(v1[0], v1[1]); w.w = cvt_pk_bf16(v1[2], v1[3]);
                    *(u32x4*)(XB + off) = w; }
                q += __shfl_xor(q, 16); q += __shfl_xor(q, 32);
                if (fq == 0) ssq[(size_t)row * 16 + u.pn * 4 + wc] = q; } }
    }
};

template <class Epi, class Sched, bool ALIGN_EPI = false, bool SP2 = false>
__device__ __forceinline__ void gemm_phase(PG8_LAS unsigned char* lds, const Gemm g, const Sched& S, const Epi& E) {
    int tid_ = threadIdx.x; asm volatile("" : "+v"(tid_));
    const int tid = tid_, wid = __builtin_amdgcn_readfirstlane(tid >> 6), lane = tid & 63, wr = wid >> 2, wc = wid & 3, fr = lane & 15, fq = lane >> 4;
    const int K = g.K, nt = K / BK;
    unsigned voffA[2], voffB[2];
#pragma unroll
    for (int i = 0; i < 2; ++i) { int R, C; stage_rc(tid * 16 + i * 8192, R, C); const int Rb = Epi::PERM ? ((R & ~31) + perm32(R & 31)) : R;
        voffA[i] = (unsigned)(R * K + C) * 2u; voffB[i] = (unsigned)(Rb * K + C) * 2u; }
    const size_t kstep = (size_t)(BK * 2);
    const size_t hstep = (size_t)HALF * K * 2;
    const size_t tstep = 2 * hstep;
    const unsigned ldsw = (unsigned)wid * 1024u;
    const int aoff = lds_byte(wr * 64 + fr, fq * 8), boff = lds_byte(wc * 32 + fr, fq * 8);
#define PG8_SA(b, h) (((b) * 2 + (h)) * HTB)
#define PG8_SB(b, h) ((4 + (b) * 2 + (h)) * HTB)
#define PG8_STAGE(bufoff, gbase, voff) do { _Pragma("unroll") for (int _i = 0; _i < 2; ++_i) \
        __builtin_amdgcn_global_load_lds((const unsigned*)((const char*)(gbase) + (voff)[_i]), (PG8_LAS unsigned*)(lds + (bufoff) + ldsw + _i * 8192), 16, 0, 0); } while (0)
#define PG8_LDA(dst, b, h) do { _Pragma("unroll") for (int m = 0; m < 4; ++m) _Pragma("unroll") for (int k = 0; k < 2; ++k) dst[m][k] = *(const PG8_LAS bf16x8*)(lds + PG8_SA(b, h) + aoff + m * 2048 + k * 1024); } while (0)
#define PG8_LDB(dst, b, h) do { _Pragma("unroll") for (int n = 0; n < 2; ++n) _Pragma("unroll") for (int k = 0; k < 2; ++k) dst[n][k] = *(const PG8_LAS bf16x8*)(lds + PG8_SB(b, h) + boff + n * 2048 + k * 1024); } while (0)
#define PG8_MMA(ai, bj, At, Bt) do { __builtin_amdgcn_s_setprio(1); _Pragma("unroll") for (int m = 0; m < 4; ++m) _Pragma("unroll") for (int n = 0; n < 2; ++n) _Pragma("unroll") for (int k = 0; k < 2; ++k) \
        acc[ai][bj][m][n] = __builtin_amdgcn_mfma_f32_16x16x32_bf16(Bt[n][k], At[m][k], acc[ai][bj][m][n], 0, 0, 0); __builtin_amdgcn_s_setprio(0); } while (0)
#define PG8_WAIT_V(n) asm volatile("s_waitcnt vmcnt(" #n ")" ::: "memory")
#define PG8_WAIT_L(n) asm volatile("s_waitcnt lgkmcnt(" #n ")" ::: "memory")
#define PG8_BAR __builtin_amdgcn_s_barrier()
#define PG8_SCHED __builtin_amdgcn_sched_barrier(0)
    Unit cur, nxt; int ui = 0;
    if (!S.next(0, cur)) return;
    f32x4 acc[2][2][4][2];
#pragma unroll
    for (int a = 0; a < 2; ++a)
#pragma unroll
        for (int b = 0; b < 2; ++b)
#pragma unroll
            for (int m = 0; m < 4; ++m)
#pragma unroll
                for (int n = 0; n < 2; ++n) acc[a][b][m][n] = (f32x4){0.f, 0.f, 0.f, 0.f};
    bf16x8 At[4][2], B0[2][2], B1[2][2];
    const char* cA = (const char*)g.A + (size_t)cur.pm * tstep; const char* cB = (const char*)g.Bt + (size_t)cur.pn * tstep;
    S.a_ready(cur);
    if constexpr (SP2) {
        PG8_STAGE(PG8_SB(0, 0), cB, voffB); PG8_STAGE(PG8_SB(0, 1), cB + hstep, voffB); PG8_STAGE(PG8_SA(0, 0), cA, voffA); PG8_STAGE(PG8_SA(0, 1), cA + hstep, voffA);
        if (wr == 1) PG8_BAR;
        PG8_WAIT_V(2); PG8_BAR;
        PG8_STAGE(PG8_SB(1, 0), cB + kstep, voffB); PG8_STAGE(PG8_SA(1, 0), cA + kstep, voffA); PG8_STAGE(PG8_SB(1, 1), cB + hstep + kstep, voffB);
        PG8_WAIT_V(6); PG8_BAR;
    } else {
        PG8_STAGE(PG8_SB(0, 0), cB, voffB); PG8_STAGE(PG8_SA(0, 0), cA, voffA); PG8_STAGE(PG8_SB(0, 1), cB + hstep, voffB); PG8_STAGE(PG8_SA(0, 1), cA + hstep, voffA);
        if (wr == 1) PG8_BAR;
        PG8_WAIT_V(4); PG8_BAR;
        PG8_STAGE(PG8_SB(1, 0), cB + kstep, voffB); PG8_STAGE(PG8_SA(1, 0), cA + kstep, voffA); PG8_STAGE(PG8_SB(1, 1), cB + hstep + kstep, voffB);
        PG8_WAIT_V(6); PG8_BAR;
    }
    for (;;) {
        const bool has_next = S.next(ui + 1, nxt);
        const char* nA = has_next ? (const char*)g.A + (size_t)nxt.pm * tstep : cA; const char* nB = has_next ? (const char*)g.Bt + (size_t)nxt.pn * tstep : cB;
        for (int t = 0; t < nt; t += 2) {
            const bool last = (t == nt - 2);
            const char* a1 = cA + (size_t)(t + 1) * kstep;
            const char* a2 = last ? nA : cA + (size_t)(t + 2) * kstep; const char* b2 = last ? nB : cB + (size_t)(t + 2) * kstep;
            const char* a3 = a2 + kstep; const char* b3 = b2 + kstep;
            if (last && has_next) S.a_ready(nxt);
            if constexpr (SP2) {
            PG8_LDB(B0, 0, 0); PG8_LDB(B1, 0, 1); PG8_SCHED; PG8_LDA(At, 0, 0); PG8_STAGE(PG8_SA(1, 1), a1 + hstep, voffA);
            PG8_WAIT_V(8); PG8_WAIT_L(0); PG8_BAR; PG8_MMA(0, 0, At, B0); PG8_MMA(0, 1, At, B1); PG8_BAR; PG8_SCHED;
            PG8_LDA(At, 0, 1); PG8_STAGE(PG8_SB(0, 0), b2, voffB); PG8_STAGE(PG8_SB(0, 1), b2 + hstep, voffB); PG8_STAGE(PG8_SA(0, 0), a2, voffA);
            PG8_WAIT_V(8); PG8_WAIT_L(0); PG8_BAR; PG8_MMA(1, 0, At, B0); PG8_MMA(1, 1, At, B1); PG8_BAR; PG8_SCHED;
            PG8_LDB(B0, 1, 0); PG8_LDB(B1, 1, 1); PG8_SCHED; PG8_LDA(At, 1, 0); PG8_STAGE(PG8_SA(0, 1), a2 + hstep, voffA);
            PG8_WAIT_V(8); PG8_WAIT_L(0); PG8_BAR; PG8_MMA(0, 0, At, B0); PG8_MMA(0, 1, At, B1); PG8_BAR; PG8_SCHED;
            PG8_LDA(At, 1, 1); PG8_STAGE(PG8_SB(1, 0), b3, voffB); PG8_STAGE(PG8_SB(1, 1), b3 + hstep, voffB); PG8_STAGE(PG8_SA(1, 0), a3, voffA);
            PG8_WAIT_V(8); PG8_WAIT_L(0); PG8_BAR; PG8_MMA(1, 0, At, B0); PG8_MMA(1, 1, At, B1); PG8_BAR; PG8_SCHED;
            } else {
            PG8_LDB(B0, 0, 0); PG8_SCHED; PG8_LDA(At, 0, 0); PG8_STAGE(PG8_SA(1, 1), a1 + hstep, voffA);
            PG8_WAIT_L(8); PG8_BAR; PG8_WAIT_L(0); PG8_MMA(0, 0, At, B0); PG8_BAR; PG8_SCHED;
            PG8_LDB(B1, 0, 1); PG8_STAGE(PG8_SB(0, 0), b2, voffB);
            PG8_BAR; PG8_WAIT_L(0); PG8_MMA(0, 1, At, B1); PG8_BAR;
            PG8_LDA(At, 0, 1); PG8_STAGE(PG8_SA(0, 0), a2, voffA);
            PG8_BAR; PG8_WAIT_L(0); PG8_MMA(1, 0, At, B0); PG8_BAR; PG8_SCHED;
            PG8_STAGE(PG8_SB(0, 1), b2 + hstep, voffB);
            PG8_WAIT_V(6); PG8_BAR; PG8_MMA(1, 1, At, B1); PG8_BAR;
            PG8_LDB(B0, 1, 0); PG8_SCHED; PG8_LDA(At, 1, 0); PG8_STAGE(PG8_SA(0, 1), a2 + hstep, voffA);
            PG8_WAIT_L(8); PG8_BAR; PG8_WAIT_L(0); PG8_MMA(0, 0, At, B0); PG8_BAR; PG8_SCHED;
            PG8_LDB(B1, 1, 1); PG8_STAGE(PG8_SB(1, 0), b3, voffB);
            PG8_BAR; PG8_WAIT_L(0); PG8_MMA(0, 1, At, B1); PG8_BAR;
            PG8_LDA(At, 1, 1); PG8_STAGE(PG8_SA(1, 0), a3, voffA);
            PG8_BAR; PG8_WAIT_L(0); PG8_MMA(1, 0, At, B0); PG8_BAR; PG8_SCHED;
            PG8_STAGE(PG8_SB(1, 1), b3 + hstep, voffB);
            PG8_WAIT_V(6); PG8_BAR; PG8_MMA(1, 1, At, B1); PG8_BAR;
            }
        }
        if constexpr (ALIGN_EPI) { if (wr == 0) PG8_BAR; }
        if constexpr (!Epi::AFTER_DRAIN) { E(acc, cur, wr, wc, fr, fq); S.done(cur); }
        if (!has_next) break;
#pragma unroll
        for (int a = 0; a < 2; ++a)
#pragma unroll
            for (int b = 0; b < 2; ++b)
#pragma unroll
                for (int m = 0; m < 4; ++m)
#pragma unroll
                    for (int n = 0; n < 2; ++n) acc[a][b][m][n] = (f32x4){0.f, 0.f, 0.f, 0.f};
        cur = nxt; cA = nA; cB = nB; ++ui;
        if constexpr (ALIGN_EPI) { if (wr == 1) PG8_BAR; }
    }
    PG8_WAIT_V(0);
    if constexpr (!ALIGN_EPI) { if (wr == 0) PG8_BAR; }
    PG8_BAR;
    if constexpr (Epi::AFTER_DRAIN) { E.fused(acc, cur, wr, wc, fr, fq, lds, wid, lane); S.done(cur); }
#undef PG8_SA
#undef PG8_SB
#undef PG8_STAGE
#undef PG8_LDA
#undef PG8_LDB
#undef PG8_MMA
#undef PG8_WAIT_V
#undef PG8_WAIT_L
#undef PG8_BAR
#undef PG8_SCHED
}
}
namespace att {
typedef unsigned short bf16;
constexpr int   D = 128, NW = 8, QBLK = 32, KVBLK = 64;
constexpr float SCALE = 0.088388347648318440f;
constexpr float THR = 8.f;
constexpr int SDEPTH = 2;
constexpr int LDQ = 4608, LDK = 4608, LDG = 4608, LDO = 2048;
constexpr size_t SHM_V = KVBLK * D * 2, SHM_K = KVBLK * D * 2, SHM_ATTN = 3 * SHM_V + 3 * SHM_K + NW * 64 * 4;
using bf16x8 = __attribute__((ext_vector_type(8))) short;
using s16x4  = __attribute__((ext_vector_type(4))) short;
using f32x16 = __attribute__((ext_vector_type(16))) float;
using f32x8  = __attribute__((ext_vector_type(8))) float;
using u32x4  = __attribute__((ext_vector_type(4))) unsigned;
#define KSWZ(row, colB) ((row) * 256 + ((colB) ^ (((row) & 15) << 4)))
#undef SBAR
#define SBAR() __builtin_amdgcn_sched_barrier(0)
__device__ __forceinline__ int crow(int r, int hi) { return (r & 3) + 8 * (r >> 2) + 4 * hi; }
__device__ __forceinline__ unsigned cvtpk(float lo, float hi) {
  unsigned r; asm volatile("v_cvt_pk_bf16_f32 %0, %1, %2" : "=v"(r) : "v"(lo), "v"(hi)); return r;
}
template <typename TIn> struct Stage;
template <> struct Stage<bf16>  { using T = bf16x8;
  __device__ static __forceinline__ T ld8(const bf16* p) { return *reinterpret_cast<const bf16x8*>(p); }
  __device__ static __forceinline__ bf16x8 tobf(T x) { return x; } };
template <> struct Stage<float> { using T = f32x8;
  __device__ static __forceinline__ T ld8(const float* p) { return *reinterpret_cast<const f32x8*>(p); }
  __device__ static __forceinline__ bf16x8 tobf(T x) {
    u32x4 w = {cvtpk(x[0], x[1]), cvtpk(x[2], x[3]), cvtpk(x[4], x[5]), cvtpk(x[6], x[7])}; return *reinterpret_cast<bf16x8*>(&w); } };

template <bool NOMAX>
__device__ __forceinline__ void partialSM(f32x16& p0, f32x16& p1, float& m_reg, float& mn, float& alpha) {
  if constexpr (NOMAX) { mn = 0.f; alpha = 1.f; for (int r = 0; r < 16; ++r) p0[r] = __builtin_amdgcn_exp2f(p0[r]); return; }
  constexpr float C = SCALE * 1.4426950408889634f;
  float pmax = p0[0]; for (int r = 1; r < 16; ++r) pmax = fmaxf(pmax, p0[r]); for (int r = 0; r < 16; ++r) pmax = fmaxf(pmax, p1[r]);
  { auto rr = __builtin_amdgcn_permlane32_swap(__float_as_uint(pmax), __float_as_uint(pmax), false, false);
    pmax = fmaxf(__uint_as_float(rr[0]), __uint_as_float(rr[1])); }
  if (__builtin_expect(__all(pmax - m_reg <= THR / SCALE), 1)) { mn = m_reg; alpha = 1.f; }
  else { mn = fmaxf(m_reg, pmax); alpha = __builtin_amdgcn_exp2f((m_reg - mn) * C); m_reg = mn; }
  float mnC = -mn * C;
  for (int r = 0; r < 16; ++r) p0[r] = fmaf(p0[r], C, mnC); for (int r = 0; r < 16; ++r) p1[r] = fmaf(p1[r], C, mnC);
  for (int r = 0; r < 16; ++r) p0[r] = __builtin_amdgcn_exp2f(p0[r]);
}
__device__ __forceinline__ void finishSM(f32x16& p0, f32x16& p1, float alpha, float& l_reg, bf16x8& pa0, bf16x8& pa1, bf16x8& pa2, bf16x8& pa3) {
  for (int r = 0; r < 16; ++r) p1[r] = __builtin_amdgcn_exp2f(p1[r]);
  float ps = 0; for (int r = 0; r < 16; ++r) ps += p0[r]; for (int r = 0; r < 16; ++r) ps += p1[r];
  { auto rr = __builtin_amdgcn_permlane32_swap(__float_as_uint(ps), __float_as_uint(ps), false, false);
    ps = __uint_as_float(rr[0]) + __uint_as_float(rr[1]); }
  l_reg = l_reg * alpha + ps;
#define PK8(P, BASE, OUT) do { u32x4 w = {cvtpk(P[BASE + 0], P[BASE + 1]), cvtpk(P[BASE + 2], P[BASE + 3]), cvtpk(P[BASE + 4], P[BASE + 5]), cvtpk(P[BASE + 6], P[BASE + 7])}; \
    OUT = *reinterpret_cast<bf16x8*>(&w); } while (0)
  PK8(p0, 0, pa0); PK8(p0, 8, pa1); PK8(p1, 0, pa2); PK8(p1, 8, pa3);
#undef PK8
}
__device__ __forceinline__ void qkt(f32x16& p0, f32x16& p1, const bf16* Ks, const bf16x8* qr, int r32, int hi) {
  p0 = f32x16{}; p1 = f32x16{};
  for (int d0 = 0; d0 < 8; ++d0) { int cb = (d0 * 16 + hi * 8) * 2;
    bf16x8 b0 = *reinterpret_cast<const bf16x8*>((const char*)Ks + KSWZ(r32, cb));
    bf16x8 b1 = *reinterpret_cast<const bf16x8*>((const char*)Ks + KSWZ(32 + r32, cb));
    p0 = __builtin_amdgcn_mfma_f32_32x32x16_bf16(b0, qr[d0], p0, 0, 0, 0);
    p1 = __builtin_amdgcn_mfma_f32_32x32x16_bf16(b1, qr[d0], p1, 0, 0, 0); }
}
__device__ __forceinline__ int v_st(int k, int c) { const int kk = (k & ~0xC) | ((k & 4) << 1) | ((k & 8) >> 1); return ((kk >> 3) * 4 + (c >> 5)) * 512 + ((kk & 7) * 32 + (c & 31)) * 2; }
__device__ __forceinline__ int v_rd_base(int lane) { return ((lane & 3) << 3) | (((lane >> 2) & 3) << 6) | (((lane >> 4) & 1) << 5) | (((lane >> 5) & 1) << 11); }
constexpr int v_rd_off(int d0, int ks, int half) { return d0 * 512 + ks * 4096 + half * 256; }
template <int OFF> __device__ __forceinline__ s16x4 tr_read(int vb) {
  s16x4 r; asm volatile("ds_read_b64_tr_b16 %0, %1 offset:%2" : "=&v"(r) : "v"(vb), "i"(OFF) : "memory"); return r;
}
struct VF { s16x4 l0, h0, l1, h1, l2, h2, l3, h3; };
template <int D0> __device__ __forceinline__ void pv_rd(VF& f, int vb) {
  f.l0 = tr_read<v_rd_off(D0, 0, 0)>(vb); f.h0 = tr_read<v_rd_off(D0, 0, 1)>(vb); f.l1 = tr_read<v_rd_off(D0, 1, 0)>(vb); f.h1 = tr_read<v_rd_off(D0, 1, 1)>(vb);
  f.l2 = tr_read<v_rd_off(D0, 2, 0)>(vb); f.h2 = tr_read<v_rd_off(D0, 2, 1)>(vb); f.l3 = tr_read<v_rd_off(D0, 3, 0)>(vb); f.h3 = tr_read<v_rd_off(D0, 3, 1)>(vb);
}
__device__ __forceinline__ void pv_mm(f32x16& od, const VF& f, bf16x8 pa0, bf16x8 pa1, bf16x8 pa2, bf16x8 pa3) {
#define PK(L, H) (bf16x8){L[0], L[1], L[2], L[3], H[0], H[1], H[2], H[3]}
  od = __builtin_amdgcn_mfma_f32_32x32x16_bf16(pa0, PK(f.l0, f.h0), od, 0, 0, 0);
  od = __builtin_amdgcn_mfma_f32_32x32x16_bf16(pa1, PK(f.l1, f.h1), od, 0, 0, 0);
  od = __builtin_amdgcn_mfma_f32_32x32x16_bf16(pa2, PK(f.l2, f.h2), od, 0, 0, 0);
  od = __builtin_amdgcn_mfma_f32_32x32x16_bf16(pa3, PK(f.l3, f.h3), od, 0, 0, 0);
#undef PK
}
__device__ __forceinline__ void pv_d0(f32x16* o, int vb, bf16x8 pa0, bf16x8 pa1, bf16x8 pa2, bf16x8 pa3) {
  VF fa, fb;
  pv_rd<0>(fa, vb);
  pv_rd<1>(fb, vb); asm volatile("s_waitcnt lgkmcnt(8)" ::: "memory"); SBAR(); pv_mm(o[0], fa, pa0, pa1, pa2, pa3); SBAR();
  pv_rd<2>(fa, vb); asm volatile("s_waitcnt lgkmcnt(8)" ::: "memory"); SBAR(); pv_mm(o[1], fb, pa0, pa1, pa2, pa3); SBAR();
  pv_rd<3>(fb, vb); asm volatile("s_waitcnt lgkmcnt(8)" ::: "memory"); SBAR(); pv_mm(o[2], fa, pa0, pa1, pa2, pa3); SBAR();
  asm volatile("s_waitcnt lgkmcnt(0)" ::: "memory"); SBAR(); pv_mm(o[3], fb, pa0, pa1, pa2, pa3);
}

template <typename TQ, int MODE, bool NOMAX>
__device__ __forceinline__ void attn_dense_body(const TQ* __restrict__ Qb, const bf16* __restrict__ Kh, const bf16* __restrict__ Vh,
                                                const bf16* __restrict__ Gb, bf16* __restrict__ Ob, int ldo, float* __restrict__ lse_out, int seq, char* lds,
                                                const float* __restrict__ qnw, const float* __restrict__ rope, int tok0) {
  using St = Stage<bf16>; using SQ = Stage<TQ>;
  int tid_ = threadIdx.x; asm volatile("" : "+v"(tid_));
  const int tid = tid_, wid = tid >> 6, lane = tid & 63, r32 = lane & 31, hi = lane >> 5;
  bf16* V_lds = (bf16*)lds; bf16* K_lds = (bf16*)(lds + 3 * SHM_V);
  float* ws = (float*)(lds + 3 * SHM_V + 3 * SHM_K) + wid * 64; float* li_l = ws; float* al_l = ws + 32;
  float m_reg = -1e30f, l_reg = 0; f32x16 o[4] = {}; bf16x8 qr[8];
  const TQ* Qw = Qb + (long)(wid * QBLK + r32) * LDQ + hi * 8;
#pragma unroll
  for (int d0 = 0; d0 < 8; ++d0) qr[d0] = SQ::tobf(SQ::ld8(Qw + d0 * 16));
  {
    float qf[8][8]; float ss = 0.f;
#pragma unroll
    for (int d0 = 0; d0 < 8; ++d0) { const u32x4 w = *reinterpret_cast<const u32x4*>(&qr[d0]);
#pragma unroll
      for (int e = 0; e < 4; ++e) { qf[d0][2 * e] = __uint_as_float(w[e] << 16); qf[d0][2 * e + 1] = __uint_as_float(w[e] & 0xffff0000u); ss += qf[d0][2 * e] * qf[d0][2 * e] + qf[d0][2 * e + 1] * qf[d0][2 * e + 1]; } }
    { auto rr = __builtin_amdgcn_permlane32_swap(__float_as_uint(ss), __float_as_uint(ss), false, false); ss = __uint_as_float(rr[0]) + __uint_as_float(rr[1]); }
    const float rs = rsqrtf(ss * (1.0f / 128.0f) + 1e-6f) * (NOMAX ? SCALE * 1.4426950408889634f : 1.f);
    const int tpos = tok0 + wid * QBLK + r32;
#pragma unroll
    for (int ax = 0; ax < 2; ++ax) { const int pos = ax ? (tpos & 63) : (tpos >> 6);
#pragma unroll
      for (int h2 = 0; h2 < 2; ++h2) { const int d1 = 4 * ax + h2, d2 = d1 + 2, i0 = h2 * 16 + hi * 8;
        const float* cp = rope + pos * 32 + i0; const float* wp1 = qnw + d1 * 16 + hi * 8; const float* wp2 = qnw + d2 * 16 + hi * 8;
        float o1[8], o2[8];
#pragma unroll
        for (int e = 0; e < 8; ++e) { const float a1 = qf[d1][e] * rs * wp1[e], a2 = qf[d2][e] * rs * wp2[e], cs = cp[e], sn = cp[4096 + e]; o1[e] = a1 * cs - a2 * sn; o2[e] = a2 * cs + a1 * sn; }
        u32x4 p1 = {cvtpk(o1[0], o1[1]), cvtpk(o1[2], o1[3]), cvtpk(o1[4], o1[5]), cvtpk(o1[6], o1[7])}, p2 = {cvtpk(o2[0], o2[1]), cvtpk(o2[2], o2[3]), cvtpk(o2[4], o2[5]), cvtpk(o2[6], o2[7])};
        qr[d1] = *reinterpret_cast<bf16x8*>(&p1); qr[d2] = *reinterpret_cast<bf16x8*>(&p2); } } }
  const int sr = tid >> 4, sc = (tid & 15) * 8, vst0 = v_st(sr, sc), vst1 = v_st(32 + sr, sc);
  const int vb0 = (int)(uintptr_t)V_lds + v_rd_base(lane);
  struct { typename St::T vs0, vs1, ks0, ks1; } sr_[1];
#define SLOAD(i, k0) do { sr_[i].vs0 = St::ld8(&Vh[(long)((k0) + sr) * LDK + sc]); sr_[i].vs1 = St::ld8(&Vh[(long)((k0) + 32 + sr) * LDK + sc]); \
    sr_[i].ks0 = St::ld8(&Kh[(long)((k0) + sr) * LDK + sc]); sr_[i].ks1 = St::ld8(&Kh[(long)((k0) + 32 + sr) * LDK + sc]); } while (0)
#define SWRITE(boff, i) do { *(bf16x8*)((char*)V_lds + (boff) + vst0) = St::tobf(sr_[i].vs0);          \
    *(bf16x8*)((char*)V_lds + (boff) + vst1) = St::tobf(sr_[i].vs1); int kc = sc * 2;               \
    *(bf16x8*)((char*)K_lds + (boff) + KSWZ(sr, kc)) = St::tobf(sr_[i].ks0);                       \
    *(bf16x8*)((char*)K_lds + (boff) + KSWZ(32 + sr, kc)) = St::tobf(sr_[i].ks1); } while (0)
#define RESC(a) do { if constexpr (!NOMAX) if (__any((a) < 1.f)) { if (hi == 0) al_l[r32] = (a); asm volatile("s_waitcnt lgkmcnt(0)" ::: "memory"); \
    for (int d = 0; d < 4; ++d) for (int r = 0; r < 16; ++r) o[d][r] *= al_l[crow(r, hi)]; } } while (0)
  f32x16 pA0, pA1, pB0, pB1; float mnA, mnB, alA, alB; bf16x8 pa0, pa1, pa2, pa3; const int NT = seq / KVBLK;
  SLOAD(0, 0); asm volatile("s_waitcnt vmcnt(0)" ::: "memory"); SWRITE(0, 0);
  SLOAD(0, KVBLK); asm volatile("s_waitcnt vmcnt(0)" ::: "memory"); SWRITE((int)SHM_V, 0);
  if (2 < NT) SLOAD(0, 2 * KVBLK);
  __syncthreads();
  qkt(pA0, pA1, K_lds, qr, r32, hi); partialSM<NOMAX>(pA0, pA1, m_reg, mnA, alA);
  int ocur = (int)SHM_V, oprev = 0, onext = 2 * (int)SHM_V;
#define STEP(PC0, PC1, ALC, MNC, PP0, PP1, ALP, T) do { \
    if ((T) + 1 < NT) { asm volatile("s_waitcnt vmcnt(0)" ::: "memory"); SWRITE(onext, 0); } \
    SBAR(); qkt(PC0, PC1, (bf16*)((char*)K_lds + ocur), qr, r32, hi); \
    finishSM(PP0, PP1, ALP, l_reg, pa0, pa1, pa2, pa3); SBAR(); \
    if ((T) + 2 < NT) SLOAD(0, ((T) + 2) * KVBLK); SBAR(); \
    pv_d0(o, vb0 + oprev, pa0, pa1, pa2, pa3); partialSM<NOMAX>(PC0, PC1, m_reg, MNC, ALC); \
    RESC(ALC); __syncthreads(); \
    { const int t_ = oprev; oprev = ocur; ocur = onext; onext = t_; } } while (0)
  for (int t = 1; t + 1 < NT; t += 2) {
    STEP(pB0, pB1, alB, mnB, pA0, pA1, alA, t);
    STEP(pA0, pA1, alA, mnA, pB0, pB1, alB, t + 1);
  }
  STEP(pB0, pB1, alB, mnB, pA0, pA1, alA, NT - 1);
  finishSM(pB0, pB1, alB, l_reg, pa0, pa1, pa2, pa3); SBAR();
  pv_d0(o, vb0 + oprev, pa0, pa1, pa2, pa3);
#undef STEP
  if (hi == 0) li_l[r32] = l_reg; asm volatile("s_waitcnt lgkmcnt(0)" ::: "memory");
  float rli[16];
#pragma unroll
  for (int r = 0; r < 16; ++r) rli[r] = __builtin_amdgcn_rcpf(li_l[crow(r, hi)]);
  bf16* Ow = Ob + (long)(wid * QBLK) * ldo; const bf16* Gw = Gb + (long)(wid * QBLK) * LDG;
  u32x4 gat[8];
  if (MODE == 0) {
#pragma unroll
    for (int it = 0; it < 8; ++it) { const int idx = it * 64 + lane; gat[it] = *reinterpret_cast<const u32x4*>(Gw + (long)(idx >> 4) * LDG + (idx & 15) * 8); } }
  __syncthreads();
  char* ost = lds + wid * 8704;
#pragma unroll
  for (int r = 0; r < 16; ++r) { const int orow = crow(r, hi);
#pragma unroll
    for (int d0 = 0; d0 < 4; ++d0) { const float v = o[d0][r] * rli[r]; *(bf16*)(ost + orow * 272 + (d0 * 32 + r32) * 2) = (bf16)(cvtpk(v, v) & 0xffffu); } }
  asm volatile("s_waitcnt lgkmcnt(0)" ::: "memory");
  if (MODE == 1) { if (hi == 0) lse_out[wid * QBLK + r32] = NOMAX ? __logf(l_reg) : m_reg * SCALE + __logf(l_reg); }
#pragma unroll
  for (int it = 0; it < 8; ++it) { const int idx = it * 64 + lane, row = idx >> 4, ck = idx & 15;
    u32x4 v = *reinterpret_cast<const u32x4*>(ost + row * 272 + ck * 16);
    if (MODE == 0) { const u32x4 g = gat[it];
#pragma unroll
      for (int e = 0; e < 4; ++e) { const float g0 = __uint_as_float(g[e] << 16), g1 = __uint_as_float(g[e] & 0xffff0000u), v0 = __uint_as_float(v[e] << 16), v1 = __uint_as_float(v[e] & 0xffff0000u);
        v[e] = cvtpk(v0 * g0 * __builtin_amdgcn_rcpf(1.f + __expf(-g0)), v1 * g1 * __builtin_amdgcn_rcpf(1.f + __expf(-g1))); } }
    *reinterpret_cast<u32x4*>(Ow + (long)row * ldo + ck * 8) = v; }
#undef SLOAD
#undef SWRITE
#undef RESC
}

}

#define LAS __attribute__((address_space(3)))
typedef unsigned short bf16_t;
typedef short bf16x8 __attribute__((ext_vector_type(8)));
typedef float f32x4 __attribute__((ext_vector_type(4)));
typedef float f32x2 __attribute__((ext_vector_type(2)));
typedef unsigned u32x4 __attribute__((ext_vector_type(4)));
typedef unsigned u32x2 __attribute__((ext_vector_type(2)));

constexpr int NB = 2, SEQL = 8192, M = NB * SEQL, DM = 1024, DIN = 4608, DMIX = 2048, DEPTH = 4;
constexpr int C_UPOOL = 0, C_GPOOL = 512, C_ULRU = 1024, C_GLRU = 1792, C_Q = 2560, C_K = 3328, C_V = 3584, C_GATT = 3840;
constexpr int Y_POOL = 0, Y_LRU = 512, Y_ATT = 1280;
constexpr int NCHUNK = 64;
constexpr size_t WS_Z = 0, WS_Y = WS_Z + (size_t)M * DIN * 2, WS_PF = WS_Y + (size_t)M * DMIX * 2, WS_PB = WS_PF + (size_t)M * 768 * 2,
                 WS_XB = WS_PF  , WS_WIN = WS_PB + (size_t)M * 768 * 2, WS_WOUT = WS_WIN + (size_t)DIN * DM * 2,
                 WS_POOLW = WS_WOUT + (size_t)DM * DMIX * 2, WS_LRUW = WS_POOLW + (size_t)DEPTH * 4 * 16384 * 2, WS_SSQ = WS_LRUW + (size_t)DEPTH * 24 * 16384 * 2,
                 WS_SUMM = WS_SSQ + (size_t)M * 16 * 4, WS_ROPE = WS_SUMM + (size_t)NB * NCHUNK * 2 * 2 * 768 * 4, WS_BAR = WS_ROPE + 2 * 128 * 32 * 4, WS_PART = WS_BAR + 16384  , WS_LSE = WS_PART + (size_t)128 * 256 * 128 * 2  , WS_END = WS_LSE + (size_t)128 * 2 * 256 * 4;
static_assert((size_t)M * DM * 2 <= 2 * (size_t)M * 768 * 2, "XB overlay fits");
static_assert(WS_END <= 301989888ull, "workspace budget (4 x largest input)");
constexpr int LDS_BYTES = 143360;

struct Args { const float* in[15]; float* out; unsigned char* ws; float inv[32]; };

__device__ __forceinline__ float bf2f(unsigned v) { return __uint_as_float(v << 16); }
__device__ __forceinline__ float bflo(unsigned w) { return __uint_as_float(w << 16); }
__device__ __forceinline__ float bfhi(unsigned w) { return __uint_as_float(w & 0xffff0000u); }
__device__ __forceinline__ unsigned pk2(float lo, float hi) { unsigned r; asm volatile("v_cvt_pk_bf16_f32 %0, %1, %2" : "=v"(r) : "v"(lo), "v"(hi)); return r; }
__device__ __forceinline__ float silu_f(float g) { return g * __builtin_amdgcn_rcpf(1.f + __expf(-g)); }
__device__ __forceinline__ float sigmoid_f(float g) { return __builtin_amdgcn_rcpf(1.f + __expf(-g)); }
__device__ __forceinline__ float wave_sum(float v) {
#pragma unroll
    for (int o = 1; o < 64; o <<= 1) v += __shfl_xor(v, o);
    return v;
}
#define LDS_WAIT() asm volatile("s_waitcnt lgkmcnt(0)" ::: "memory")

__device__ __forceinline__ void transpose_item(const float* W, int N, bf16_t* WT, int K, const float* kscale, LAS float* scr, int kb, int nb, int lane) {
    const int k0 = 64 * kb, n0 = 32 * nb;
#pragma unroll
    for (int i = 0; i < 32; ++i) { const int kk = 2 * i + (lane >> 5); float v = W[(size_t)(k0 + kk) * N + n0 + (lane & 31)]; if (kscale) v *= kscale[k0 + kk]; scr[kk * 33 + (lane & 31)] = v; }
    LDS_WAIT();
    const int c = lane & 7;
#pragma unroll
    for (int j = 0; j < 4; ++j) { const int n = (lane >> 3) + 8 * j; const LAS float* s = scr + (8 * c) * 33 + n;
        u32x4 o; o.x = pk2(s[0 * 33], s[1 * 33]); o.y = pk2(s[2 * 33], s[3 * 33]); o.z = pk2(s[4 * 33], s[5 * 33]); o.w = pk2(s[6 * 33], s[7 * 33]);
        *(u32x4*)(WT + (size_t)(n0 + n) * K + k0 + 8 * c) = o; }
    LDS_WAIT();
}
__device__ __forceinline__ void transpose_win(const Args& a, int l, LAS float* scr, int gw, int NGW, int lane) {
    const float* W = a.in[2] + (size_t)l * DM * DIN; bf16_t* WT = (bf16_t*)(a.ws + WS_WIN); const float* g = a.in[1] + l * DM;
    for (int it = gw; it < (DM / 64) * (DIN / 32); it += NGW) transpose_item(W, DIN, WT, DM, g, scr, it / (DIN / 32), it % (DIN / 32), lane);
}
__device__ __forceinline__ void transpose_wout(const Args& a, int l, LAS float* scr, int gw, int NGW, int lane) {
    const float* W = a.in[14] + (size_t)l * DMIX * DM; bf16_t* WT = (bf16_t*)(a.ws + WS_WOUT);
    for (int it = gw; it < (DMIX / 64) * (DM / 32); it += NGW) transpose_item(W, DM, WT, DMIX, nullptr, scr, it / (DM / 32), it % (DM / 32), lane);
}

__device__ __forceinline__ void sincos_d(double x, float& c, float& s) {
    const double TWO_PI = 6.283185307179586476925287;
    const double r = x - TWO_PI * rint(x / TWO_PI), r2 = r * r;
    double sv = 0.0, cv = 0.0;
#pragma unroll
    for (int k = 14; k >= 0; --k) { sv = sv * r2 / ((2.0 * k + 2.0) * (2.0 * k + 3.0)); sv = 1.0 - sv; cv = cv * r2 / ((2.0 * k + 1.0) * (2.0 * k + 2.0)); cv = 1.0 - cv; }
    s = (float)(sv * r); c = (float)cv;
}
__device__ __forceinline__ void p0_prologue(const Args& a, LAS unsigned char* lds) {
    int tid_ = threadIdx.x; asm volatile("" : "+v"(tid_));
    const int tid = tid_, lane = tid & 63, wid = tid >> 6, G = gridDim.x, gw = blockIdx.x * 8 + wid, NGW = G * 8;
    LAS float* scr = (LAS float*)(lds + wid * 8448);
    transpose_win(a, 0, scr, gw, NGW, lane);
    for (int it = gw; it < (16 + 96) * 8; it += NGW) { const int mat = it >> 3, sub = it & 7; const float* W; bf16_t* WT;
        if (mat < 16) { W = a.in[3] + (size_t)mat * 16384; WT = (bf16_t*)(a.ws + WS_POOLW) + (size_t)mat * 16384; }
        else { const int q = mat - 16, gate = q / 48, r = q % 48, l = r / 12, dir = (r % 12) / 6, blk = r % 6;
            W = a.in[gate ? 9 : 7] + (size_t)r * 16384; WT = (bf16_t*)(a.ws + WS_LRUW) + ((((size_t)l * 6 + blk) * 2 + dir) * 2 + gate) * 16384; }
        transpose_item(W, 128, WT, 128, nullptr, scr, sub >> 2, sub & 3, lane); }
    bf16_t* XB = (bf16_t*)(a.ws + WS_XB); float* ssq = (float*)(a.ws + WS_SSQ);
    for (int m0 = 2 * gw; m0 < M; m0 += 2 * NGW) { f32x4 v[2][4]; float s[2] = {0.f, 0.f};
#pragma unroll
        for (int q = 0; q < 2; ++q) { const f32x4* xr = (const f32x4*)(a.in[0] + (size_t)(m0 + q) * DM) + lane;
#pragma unroll
            for (int j = 0; j < 4; ++j) v[q][j] = xr[64 * j]; }
#pragma unroll
        for (int q = 0; q < 2; ++q) { const int m = m0 + q;
#pragma unroll
            for (int j = 0; j < 4; ++j) s[q] += (v[q][j][0] * v[q][j][0] + v[q][j][1] * v[q][j][1]) + (v[q][j][2] * v[q][j][2] + v[q][j][3] * v[q][j][3]);
            s[q] = wave_sum(s[q]);
            u32x2* o8 = (u32x2*)(XB + (size_t)m * DM) + lane;
#pragma unroll
            for (int j = 0; j < 4; ++j) { u32x2 w; w.x = pk2(v[q][j][0], v[q][j][1]); w.y = pk2(v[q][j][2], v[q][j][3]); o8[64 * j] = w; }
            if (lane < 16) ssq[(size_t)m * 16 + lane] = lane == 0 ? s[q] : 0.f; } }
    float* rope = (float*)(a.ws + WS_ROPE);
    for (int e = blockIdx.x * 512 + tid; e < 128 * 32; e += G * 512) { const float ang = (float)(e >> 5) * a.inv[e & 31]; float c, s; sincos_d((double)ang, c, s); rope[e] = c; rope[4096 + e] = s; }
}

template <int DIR>
__device__ __forceinline__ void lru_scan(f32x4 (&accR)[8], f32x4 (&accI)[8], const LAS bf16_t* At, float vbr, float vbi, float clam, int d, int fr, int fq, int lane, float& Pc_out, float& hc_out) {
    const int qo = DIR ? 3 - fq : fq, src1 = (DIR ? lane + 16 : lane - 16) & 63, src2 = (DIR ? lane + 32 : lane - 32) & 63, lastl = DIR ? fr : 48 + fr;
    float Pc = 1.f, hc = 0.f;
#pragma unroll
    for (int ms = 0; ms < 8; ++ms) { const int m = DIR ? 7 - ms : ms;
        float Pl[4], hl[4]; float P = 1.f, h = 0.f;
#pragma unroll
        for (int s = 0; s < 4; ++s) { const int j = DIR ? 3 - s : s; const int tok = m * 16 + 4 * fq + j;
            const float r = __builtin_amdgcn_rcpf(1.f + __builtin_amdgcn_exp2f(fmaf(accR[m][j], -1.4426950408889634f, vbr)));
            const float ig = __builtin_amdgcn_rcpf(1.f + __builtin_amdgcn_exp2f(fmaf(accI[m][j], -1.4426950408889634f, vbi)));
            const float aa = __builtin_amdgcn_exp2f(clam * r);
            const float om = fmaxf(fmaf(-aa, aa, 1.f), 0.f);
            const float x = bf2f(At[tok * 136 + d]);
            const float inp = __builtin_amdgcn_sqrtf(om) * (ig * x);
            h = aa * h + inp; P = P * aa; Pl[s] = P; hl[s] = h; }
        float Pt = P, ht = h, Pp, hp;
        Pp = __shfl(Pt, src1); hp = __shfl(ht, src1); if (qo >= 1) { ht = ht + Pt * hp; Pt = Pt * Pp; }
        Pp = __shfl(Pt, src2); hp = __shfl(ht, src2); if (qo >= 2) { ht = ht + Pt * hp; Pt = Pt * Pp; }
        float Pe = __shfl(Pt, src1), he = __shfl(ht, src1); if (qo == 0) { Pe = 1.f; he = 0.f; }
        const float h_in = he + Pe * hc, P_in = Pe * Pc;
#pragma unroll
        for (int s = 0; s < 4; ++s) { const int j = DIR ? 3 - s : s; accR[m][j] = hl[s] + Pl[s] * h_in; accI[m][j] = Pl[s] * P_in; }
        hc = __shfl(accR[m][DIR ? 0 : 3], lastl); Pc = __shfl(accI[m][DIR ? 0 : 3], lastl); }
    Pc_out = Pc; hc_out = hc;
}
__device__ __forceinline__ void lru_tile(const Args& a, int l, int b, int c, int k, LAS unsigned char* lds, unsigned* xb_readers = nullptr, unsigned need = 0u) {
    int tid_ = threadIdx.x; asm volatile("" : "+v"(tid_));
    const int tid = tid_, lane = tid & 63, wid = __builtin_amdgcn_readfirstlane(tid >> 6), fr = lane & 15, fq = lane >> 4;
    LAS bf16_t* At = (LAS bf16_t*)lds;
    LAS bf16_t* Ost = (LAS bf16_t*)(lds + 34816);
    const bf16_t* Z = (const bf16_t*)(a.ws + WS_Z); bf16_t* Y = (bf16_t*)(a.ws + WS_Y);
    const int t0 = c * 128; const size_t r0 = (size_t)b * SEQL + t0;
    const int d = wid * 16 + fr;
    bf16x8 wR[2][4], wI[2][4];
#pragma unroll
    for (int dir = 0; dir < 2; ++dir) { const bf16_t* WT = (const bf16_t*)(a.ws + WS_LRUW) + ((((size_t)l * 6 + k) * 2 + dir) * 2) * 16384;
#pragma unroll
        for (int kk = 0; kk < 4; ++kk) { const size_t o = (size_t)d * 128 + kk * 32 + fq * 8; wR[dir][kk] = *(const bf16x8*)(WT + o); wI[dir][kk] = *(const bf16x8*)(WT + 16384 + o); } }
    {
        const int cgi = tid & 15, tg = tid >> 4, ch = k * 128 + cgi * 8;
        const float* cw = a.in[5] + (size_t)l * 4 * 768 + ch; const float* cb = a.in[6] + (size_t)l * 768 + ch;
        float w[4][8], bb[8];
#pragma unroll
        for (int kk = 0; kk < 4; ++kk) { const f32x4 w0 = *(const f32x4*)(cw + kk * 768), w1 = *(const f32x4*)(cw + kk * 768 + 4);
#pragma unroll
            for (int e = 0; e < 4; ++e) { w[kk][e] = w0[e]; w[kk][4 + e] = w1[e]; } }
        { const f32x4 b0 = *(const f32x4*)cb, b1 = *(const f32x4*)(cb + 4);
#pragma unroll
          for (int e = 0; e < 4; ++e) { bb[e] = b0[e]; bb[4 + e] = b1[e]; } }
        float u[7][8];
#pragma unroll
        for (int i = 0; i < 7; ++i) { const int t = t0 + tg * 4 - 1 + i; u32x4 raw = {0u, 0u, 0u, 0u};
            if (t >= 0 && t < SEQL) raw = *(const u32x4*)(Z + ((size_t)b * SEQL + t) * DIN + C_ULRU + ch);
#pragma unroll
            for (int e = 0; e < 4; ++e) { u[i][2 * e] = bflo(raw[e]); u[i][2 * e + 1] = bfhi(raw[e]); } }
#pragma unroll
        for (int i = 0; i < 4; ++i) { float xc[8];
#pragma unroll
            for (int e = 0; e < 8; ++e) xc[e] = bb[e] + u[i][e] * w[0][e] + u[i + 1][e] * w[1][e] + u[i + 2][e] * w[2][e] + u[i + 3][e] * w[3][e];
            u32x4 o; o.x = pk2(xc[0], xc[1]); o.y = pk2(xc[2], xc[3]); o.z = pk2(xc[4], xc[5]); o.w = pk2(xc[6], xc[7]);
            *(LAS u32x4*)(At + (tg * 4 + i) * 136 + cgi * 8) = o; }
    }
    __syncthreads();
    f32x4 hf[8];
#pragma unroll
    for (int dir = 0; dir < 2; ++dir) {
        const float* br = a.in[8] + ((size_t)l * 2 + dir) * 768 + k * 128; const float* bi = a.in[10] + ((size_t)l * 2 + dir) * 768 + k * 128; const float* lam = a.in[11] + ((size_t)l * 2 + dir) * 768 + k * 128;
        float* summ = (float*)(a.ws + WS_SUMM) + ((((size_t)b * NCHUNK + c) * 2 + dir) * 2) * 768 + k * 128;
        f32x4 accR[8], accI[8];
#pragma unroll
        for (int m = 0; m < 8; ++m) { accR[m] = (f32x4){0.f, 0.f, 0.f, 0.f}; accI[m] = (f32x4){0.f, 0.f, 0.f, 0.f}; }
        {
#pragma unroll
          for (int m = 0; m < 8; ++m) { bf16x8 af[4];
#pragma unroll
              for (int kk = 0; kk < 4; ++kk) af[kk] = *(const LAS bf16x8*)(At + (m * 16 + fr) * 136 + kk * 32 + fq * 8);
#pragma unroll
              for (int kk = 0; kk < 4; ++kk) { accR[m] = __builtin_amdgcn_mfma_f32_16x16x32_bf16(af[kk], wR[dir][kk], accR[m], 0, 0, 0);
                                               accI[m] = __builtin_amdgcn_mfma_f32_16x16x32_bf16(af[kk], wI[dir][kk], accI[m], 0, 0, 0); } } }
        const float lm = lam[d], clam = 8.0f * 1.4426950408889634f * (fminf(lm, 0.f) - log1pf(__expf(-fabsf(lm))));
        const float nbr = -1.4426950408889634f * br[d], nbi = -1.4426950408889634f * bi[d];
        float Pc, hc;
        if (dir == 0) lru_scan<0>(accR, accI, At, nbr, nbi, clam, d, fr, fq, lane, Pc, hc);
        else          lru_scan<1>(accR, accI, At, nbr, nbi, clam, d, fr, fq, lane, Pc, hc);
        if (fq == 0) { summ[d] = Pc; summ[768 + d] = hc; }
        LAS bf16_t* Pst = Ost + (1 + dir) * (128 * 136);
#pragma unroll
        for (int m = 0; m < 8; ++m)
#pragma unroll
            for (int j = 0; j < 4; ++j) { const int tok = m * 16 + 4 * fq + j;
                Pst[tok * 136 + d] = (bf16_t)(pk2(accI[m][j], 0.f) & 0xffffu);
                if (dir == 0) hf[m][j] = accR[m][j]; else Ost[tok * 136 + d] = (bf16_t)(pk2(hf[m][j] + accR[m][j], 0.f) & 0xffffu); }
    }
    if (need) { if (tid == 0) { unsigned sp = 0; while (__hip_atomic_load(xb_readers, __ATOMIC_RELAXED, __HIP_MEMORY_SCOPE_AGENT) < need) { __builtin_amdgcn_s_sleep(2); if (++sp > (1u << 22)) break; } } }
    __syncthreads();
    {
        bf16_t* PF = (bf16_t*)(a.ws + WS_PF); bf16_t* PB = (bf16_t*)(a.ws + WS_PB);
#pragma unroll
        for (int i = 0; i < 12; ++i) { const int idx = tid + i * 512, arr = idx >> 11, row = (idx >> 4) & 127, ck = idx & 15;
            const u32x4 v = *(const LAS u32x4*)(Ost + arr * (128 * 136) + row * 136 + ck * 8);
            bf16_t* dst = arr == 0 ? Y + (r0 + row) * DMIX + Y_LRU + k * 128 + ck * 8 : (arr == 1 ? PF : PB) + (r0 + row) * 768 + k * 128 + ck * 8;
            *(u32x4*)dst = v; }
    }
}
__device__ __forceinline__ void pool_tile(const Args& a, int l, int b, int c, int g, LAS unsigned char* lds) {
    int tid_ = threadIdx.x; asm volatile("" : "+v"(tid_));
    const int tid = tid_, lane = tid & 63, wid = tid >> 6, fr = lane & 15, fq = lane >> 4;
    LAS bf16_t* U = (LAS bf16_t*)lds;
    LAS bf16_t* At = (LAS bf16_t*)(lds + 39168);
    LAS bf16_t* Wl = (LAS bf16_t*)(lds + 73984);
    const bf16_t* Z = (const bf16_t*)(a.ws + WS_Z); bf16_t* Y = (bf16_t*)(a.ws + WS_Y);
    const int t0 = c * 128; const size_t r0 = (size_t)b * SEQL + t0; const size_t row = r0 + wid * 16 + fr;
    const bf16_t* WT = (const bf16_t*)(a.ws + WS_POOLW) + ((size_t)l * 4 + g) * 16384;
    u32x4 ur[5], wr_[4]; u32x2 gp[8]; f32x4 sc[8];
#pragma unroll
    for (int i = 0; i < 5; ++i) { const int idx = tid + i * 512, rw = idx >> 4, ck = idx & 15, t = t0 - 8 + rw; ur[i] = (u32x4){0u, 0u, 0u, 0u};
        if (idx < 144 * 16 && t >= 0 && t < SEQL) ur[i] = *(const u32x4*)(Z + ((size_t)b * SEQL + t) * DIN + C_UPOOL + g * 128 + ck * 8); }
#pragma unroll
    for (int i = 0; i < 4; ++i) { const int idx = tid + i * 512; wr_[i] = *(const u32x4*)(WT + (size_t)idx * 8); }
#pragma unroll
    for (int n = 0; n < 8; ++n) { const int d0 = n * 16 + 4 * fq; gp[n] = *(const u32x2*)(Z + row * DIN + C_GPOOL + g * 128 + d0); sc[n] = *(const f32x4*)(a.in[4] + (size_t)l * 512 + g * 128 + d0); }
#pragma unroll
    for (int i = 0; i < 5; ++i) { const int idx = tid + i * 512, rw = idx >> 4, ck = idx & 15; if (idx < 144 * 16) *(LAS u32x4*)(U + rw * 136 + ck * 8) = ur[i]; }
#pragma unroll
    for (int i = 0; i < 4; ++i) { const int idx = tid + i * 512, rw = idx >> 4, ck = idx & 15; *(LAS u32x4*)(Wl + rw * 136 + ck * 8) = wr_[i]; }
    __syncthreads();
    { const int cgi = tid & 15, tg = tid >> 4, half = 1 << g;
#pragma unroll
      for (int i = 0; i < 4; ++i) { const int tl = tg * 4 + i, t = t0 + tl; const int lo = max(t - half, 0), hi = min(t + half, SEQL);
          float s[8];
#pragma unroll
          for (int e = 0; e < 8; ++e) s[e] = 0.f;
          for (int rr = lo; rr < hi; ++rr) { const u32x4 raw = *(const LAS u32x4*)(U + (rr - t0 + 8) * 136 + cgi * 8);
#pragma unroll
              for (int e = 0; e < 4; ++e) { s[2 * e] += bflo(raw[e]); s[2 * e + 1] += bfhi(raw[e]); } }
          const float inv = 1.0f / (float)(hi - lo);
          const u32x4 self = *(const LAS u32x4*)(U + (tl + 8) * 136 + cgi * 8);
          u32x4 o;
#pragma unroll
          for (int e = 0; e < 4; ++e) o[e] = pk2(s[2 * e] * inv - bflo(self[e]), s[2 * e + 1] * inv - bfhi(self[e]));
          *(LAS u32x4*)(At + tl * 136 + cgi * 8) = o; } }
    __syncthreads();
    f32x4 acc[8];
#pragma unroll
    for (int n = 0; n < 8; ++n) acc[n] = (f32x4){0.f, 0.f, 0.f, 0.f};
#pragma unroll
    for (int kk = 0; kk < 4; ++kk) { const bf16x8 af = *(const LAS bf16x8*)(At + (wid * 16 + fr) * 136 + kk * 32 + fq * 8);
#pragma unroll
        for (int n = 0; n < 8; ++n) { const bf16x8 wf = *(const LAS bf16x8*)(Wl + (n * 16 + fr) * 136 + kk * 32 + fq * 8);
            acc[n] = __builtin_amdgcn_mfma_f32_16x16x32_bf16(wf, af, acc[n], 0, 0, 0); } }
#pragma unroll
    for (int n = 0; n < 8; ++n) { const int d0 = n * 16 + 4 * fq;
        u32x2 o; o.x = pk2(acc[n][0] * sc[n][0] * silu_f(bflo(gp[n].x)), acc[n][1] * sc[n][1] * silu_f(bfhi(gp[n].x)));
                 o.y = pk2(acc[n][2] * sc[n][2] * silu_f(bflo(gp[n].y)), acc[n][3] * sc[n][3] * silu_f(bfhi(gp[n].y)));
        *(u32x2*)(Y + row * DMIX + Y_POOL + g * 128 + d0) = o; }
}
__device__ __forceinline__ void rope_unit(const Args& a, int l, int unit, bool wr = true) {
    int tid_ = threadIdx.x; asm volatile("" : "+v"(tid_));
    const int tid = tid_, s16 = tid & 15, ax = s16 >> 3, i0 = (s16 & 7) * 4, kh = (tid >> 4) & 1;
    bf16_t* Z = (bf16_t*)(a.ws + WS_Z); const float* rope = (const float*)(a.ws + WS_ROPE);
    const float* nw = a.in[13] + l * 128 + 64 * ax + i0;
    const f32x4 w1 = *(const f32x4*)nw, w2 = *(const f32x4*)(nw + 32);
    u32x2 r1[8], r2[8]; f32x4 cs[8], sn[8];
#pragma unroll
    for (int it = 0; it < 8; ++it) { const int ri = it * 32 + (tid >> 4), tok = unit * 128 + (ri >> 1);
        const bf16_t* p = Z + (size_t)tok * DIN + C_K + kh * 128 + 64 * ax + i0;
        r1[it] = *(const u32x2*)p; r2[it] = *(const u32x2*)(p + 32);
        const int tpos = tok & (SEQL - 1), pos = ax ? (tpos & 63) : (tpos >> 6);
        cs[it] = *(const f32x4*)(rope + pos * 32 + i0); sn[it] = *(const f32x4*)(rope + 4096 + pos * 32 + i0); }
#pragma unroll
    for (int it = 0; it < 8; ++it) { const int ri = it * 32 + (tid >> 4), tok = unit * 128 + (ri >> 1);
        bf16_t* p = Z + (size_t)tok * DIN + C_K + kh * 128 + 64 * ax + i0;
        float x1[4] = {bflo(r1[it].x), bfhi(r1[it].x), bflo(r1[it].y), bfhi(r1[it].y)}, x2[4] = {bflo(r2[it].x), bfhi(r2[it].x), bflo(r2[it].y), bfhi(r2[it].y)};
        float ss = 0.f;
#pragma unroll
        for (int e = 0; e < 4; ++e) ss += x1[e] * x1[e] + x2[e] * x2[e];
        ss += __shfl_xor(ss, 1); ss += __shfl_xor(ss, 2); ss += __shfl_xor(ss, 4); ss += __shfl_xor(ss, 8);
        const float rs = rsqrtf(ss * (1.0f / 128.0f) + 1e-6f);
        float o1[4], o2[4];
#pragma unroll
        for (int e = 0; e < 4; ++e) { const float a1 = x1[e] * rs * w1[e], a2 = x2[e] * rs * w2[e]; o1[e] = a1 * cs[it][e] - a2 * sn[it][e]; o2[e] = a2 * cs[it][e] + a1 * sn[it][e]; }
        u32x2 q1, q2; q1.x = pk2(o1[0], o1[1]); q1.y = pk2(o1[2], o1[3]); q2.x = pk2(o2[0], o2[1]); q2.y = pk2(o2[2], o2[3]);
        if (wr) { *(u32x2*)p = q1; *(u32x2*)(p + 32) = q2; } }
}
__device__ __forceinline__ void fixup_unit(const Args& a, int f, LAS unsigned char* lds, bool wr = true) {
    int tid_ = threadIdx.x; asm volatile("" : "+v"(tid_));
    const int tid = tid_, b = f >> 7, c = (f >> 1) & 63, hc = f & 1, ch0 = hc * 384;
    LAS float* car = (LAS float*)lds;
    const float* summ = (const float*)(a.ws + WS_SUMM) + (size_t)b * NCHUNK * 4 * 768 + ch0;
    __syncthreads();
    {
        float H[2] = {0.f, 0.f}; int dr[2], ch[2]; bool live[2];
#pragma unroll
        for (int i = 0; i < 2; ++i) { const int q = tid + 512 * i; live[i] = q < 768; dr[i] = q >= 384; ch[i] = q - 384 * dr[i]; }
        const int nsteps = max(c, NCHUNK - 1 - c);
        for (int s0 = 0; s0 < nsteps; s0 += 16) { float P[2][16], h[2][16];
#pragma unroll
            for (int e = 0; e < 16; ++e)
#pragma unroll
                for (int i = 0; i < 2; ++i) { const int st = s0 + e, j = dr[i] ? NCHUNK - 1 - st : st; const bool ok = live[i] && (dr[i] ? (j > c) : (j < c));
                    P[i][e] = 1.f; h[i][e] = 0.f;
                    if (ok) { const float* sp = summ + ((size_t)j * 4 + 2 * dr[i]) * 768 + ch[i]; P[i][e] = sp[0]; h[i][e] = sp[768]; } }
#pragma unroll
            for (int e = 0; e < 16; ++e)
#pragma unroll
                for (int i = 0; i < 2; ++i) H[i] = h[i][e] + P[i][e] * H[i]; }
#pragma unroll
        for (int i = 0; i < 2; ++i) if (live[i]) car[tid + 512 * i] = H[i];
    }
    __syncthreads();
    const bf16_t* Z = (const bf16_t*)(a.ws + WS_Z); bf16_t* Y = (bf16_t*)(a.ws + WS_Y); const bf16_t* PF = (const bf16_t*)(a.ws + WS_PF); const bf16_t* PB = (const bf16_t*)(a.ws + WS_PB);
    const size_t r0 = (size_t)b * SEQL + c * 128;
#pragma unroll
    for (int bt = 0; bt < 2; ++bt) {
        u32x4 hs[6], pf[6], pb[6], gg[6];
#pragma unroll
        for (int i = 0; i < 6; ++i) { const int idx = tid + (bt * 6 + i) * 512, row = idx / 48, ck = idx - row * 48, cc = ch0 + ck * 8; const size_t rr = r0 + row;
            hs[i] = *(const u32x4*)(Y + rr * DMIX + Y_LRU + cc); pf[i] = *(const u32x4*)(PF + rr * 768 + cc); pb[i] = *(const u32x4*)(PB + rr * 768 + cc); gg[i] = *(const u32x4*)(Z + rr * DIN + C_GLRU + cc); }
#pragma unroll
        for (int i = 0; i < 6; ++i) { const int idx = tid + (bt * 6 + i) * 512, row = idx / 48, ck = idx - row * 48, cc = ch0 + ck * 8; const size_t rr = r0 + row;
            const f32x4 f0 = *(const LAS f32x4*)(car + ck * 8), f1 = *(const LAS f32x4*)(car + ck * 8 + 4), b0 = *(const LAS f32x4*)(car + 384 + ck * 8), b1 = *(const LAS f32x4*)(car + 384 + ck * 8 + 4);
            const float cf[8] = {f0[0], f0[1], f0[2], f0[3], f1[0], f1[1], f1[2], f1[3]}, cb[8] = {b0[0], b0[1], b0[2], b0[3], b1[0], b1[1], b1[2], b1[3]};
            u32x4 o;
#pragma unroll
            for (int e = 0; e < 4; ++e) o[e] = pk2((bflo(hs[i][e]) + bflo(pf[i][e]) * cf[2 * e] + bflo(pb[i][e]) * cb[2 * e]) * silu_f(bflo(gg[i][e])),
                                                   (bfhi(hs[i][e]) + bfhi(pf[i][e]) * cf[2 * e + 1] + bfhi(pb[i][e]) * cb[2 * e + 1]) * silu_f(bfhi(gg[i][e])));
            if (wr) *(u32x4*)(Y + rr * DMIX + Y_LRU + cc) = o; } }
}

#define XB_TMO      128
#define XB_XCNT(j)  (256  + 64 * (j))
#define XB_XSUB(j)  (1280 + 64 * (j))
#define XB_XGEN(j)  (2304 + 64 * (j))
#define XB_TOP      3328
#define XB_TOPGEN   3392
#define XCD_BAR_WORDS 3456
#define XB_SPIN_CAP (1u << 18)

__device__ __forceinline__ unsigned xb_ld(unsigned* p)              { return __hip_atomic_load(p, __ATOMIC_RELAXED, __HIP_MEMORY_SCOPE_AGENT); }
__device__ __forceinline__ unsigned xb_add(unsigned* p, unsigned v) { return __hip_atomic_fetch_add(p, v, __ATOMIC_RELAXED, __HIP_MEMORY_SCOPE_AGENT); }
__device__ __forceinline__ unsigned xb_xcc_id() { return (unsigned)__builtin_amdgcn_s_getreg((3 << 11) | 20) & 0xFu; }
#define XB_SPIN(cond, bar) do { unsigned _sp = 0; while (cond) { __builtin_amdgcn_s_sleep(1); \
    if ((++_sp & 255u) == 0u) { if (xb_ld(&(bar)[XB_TMO])) break; if (_sp > XB_SPIN_CAP) { atomicAdd(&(bar)[XB_TMO], 1u); break; } } } } while (0)

struct XcdBarrier {
    unsigned* bar; unsigned x;
    volatile LAS unsigned* st;
};

__device__ __forceinline__ XcdBarrier xcd_barrier_post(unsigned* bar, volatile LAS unsigned* st) {
    XcdBarrier b; b.bar = bar; b.x = xb_xcc_id(); b.st = st;
    if (threadIdx.x == 0) (void)xb_add(&bar[XB_XCNT(b.x)], 1u);
    return b;
}
__device__ __forceinline__ void xcd_barrier_complete(unsigned* bar, unsigned x, unsigned& nloc, unsigned& nx) {
    const unsigned G = gridDim.x * gridDim.y * gridDim.z;
    unsigned sum, cnt, mine, sp = 0u;
    for (;;) {
        sum = 0u; cnt = 0u; mine = 0u;
#pragma unroll
        for (unsigned j = 0; j < 16; ++j) { const unsigned c = xb_ld(&bar[XB_XCNT(j)]); sum += c; cnt += (c > 0u) ? 1u : 0u; mine = (j == x) ? c : mine; }
        if (sum == G) break;
        __builtin_amdgcn_s_sleep(1);
        if ((++sp & 255u) == 0u) { if (xb_ld(&bar[XB_TMO])) break; if (sp > XB_SPIN_CAP) { atomicAdd(&bar[XB_TMO], 1u); break; } }
    }
    nloc = mine > 0u ? mine : 1u; nx = cnt > 0u ? cnt : 1u;
}

__device__ __forceinline__ void xcd_barrier(const XcdBarrier& b) {
    asm volatile("s_waitcnt vmcnt(0)" ::: "memory");
    __syncthreads();
    if (threadIdx.x == 0) {
        unsigned* bar = b.bar; const unsigned bx = xb_xcc_id();
        __builtin_amdgcn_s_waitcnt(0);
        unsigned nloc = b.st[0], nx = b.st[1];
        if (nloc == 0u) { xcd_barrier_complete(bar, bx, nloc, nx); b.st[0] = nloc; b.st[1] = nx; }
        const unsigned old = xb_add(&bar[XB_XSUB(bx)], 1u);
        const unsigned gen = old / nloc;
        if (old + 1u == (gen + 1u) * nloc) {
            __builtin_amdgcn_fence(__ATOMIC_RELEASE, "agent");
            asm volatile("s_waitcnt vmcnt(0)" ::: "memory");
            const unsigned og = xb_add(&bar[XB_TOP], 1u);
            const unsigned tg = og / nx;
            if (og + 1u == (tg + 1u) * nx) xb_add(&bar[XB_TOPGEN], 1u);
            else XB_SPIN(xb_ld(&bar[XB_TOPGEN]) == tg, bar);
            __builtin_amdgcn_fence(__ATOMIC_ACQUIRE, "agent");
            xb_add(&bar[XB_XGEN(bx)], 1u);
            asm volatile("s_waitcnt vmcnt(0)" ::: "memory");
        } else {
            XB_SPIN(xb_ld(&bar[XB_XGEN(bx)]) == gen, bar);
            __builtin_amdgcn_fence(__ATOMIC_ACQUIRE, "agent");
            asm volatile("s_waitcnt vmcnt(0)" ::: "memory");
        }
    }
    __syncthreads();
}

#ifndef REP_A
#define REP_A 1
#endif
#ifndef REP_LRU
#define REP_LRU 1
#endif
#ifndef REP_POOL
#define REP_POOL 1
#endif
#ifndef REP_ATT
#define REP_ATT 1
#endif
#ifndef REP_ATTH
#define REP_ATTH 1
#endif
__global__ void __launch_bounds__(512) mega(Args a) {
    extern __shared__ __attribute__((aligned(16))) unsigned char lds_raw[];
    LAS unsigned char* lds = (LAS unsigned char*)lds_raw;
    if (a.inv[31] < 0.f) cg::this_grid().sync();
    volatile LAS unsigned* bst = (volatile LAS unsigned*)(lds + LDS_BYTES - 16);
    if (threadIdx.x < 2) bst[threadIdx.x] = 0u;
    __syncthreads();
    const XcdBarrier xbar = xcd_barrier_post((unsigned*)(a.ws + WS_BAR), bst);
    const int G = gridDim.x, bid = blockIdx.x, NGW = G * 8;
    bf16_t* Z = (bf16_t*)(a.ws + WS_Z); bf16_t* Y = (bf16_t*)(a.ws + WS_Y); bf16_t* XB = (bf16_t*)(a.ws + WS_XB);
    float* ssq = (float*)(a.ws + WS_SSQ);

#ifndef NO_P0
    p0_prologue(a, lds);
#endif
    xcd_barrier(xbar);
    for (int l = 0; l < DEPTH; ++l) {
#define PA_PART(NCOLS, COL0) do { pg8::Gemm g{XB, (const bf16_t*)(a.ws + WS_WIN) + (size_t)(COL0) * DM, M, (NCOLS), DM}; pg8::StaticOrder S; S.init(M, (NCOLS), G, bid); \
            \
          LAS float* rsl = (LAS float*)(lds + 131072); LAS int* pml = (LAS int*)(lds + 131072 + 8192); \
          { int tid_ = threadIdx.x; asm volatile("" : "+v"(tid_)); \
            __syncthreads(); \
            for (int i = 0; i < 8; ++i) { pg8::Unit u; const bool ok = S.next(i, u); if (tid_ == 0) pml[i] = ok ? u.pm : -1; \
                if (ok && tid_ < 256) { const f32x4* sp = (const f32x4*)(ssq + ((size_t)u.pm * 256 + tid_) * 16); const f32x4 s0 = sp[0], s1 = sp[1], s2 = sp[2], s3 = sp[3]; \
                    const float sum = (((s0[0] + s0[1]) + (s0[2] + s0[3])) + ((s1[0] + s1[1]) + (s1[2] + s1[3]))) + (((s2[0] + s2[1]) + (s2[2] + s2[3])) + ((s3[0] + s3[1]) + (s3[2] + s3[3]))); \
                    rsl[i * 256 + tid_] = rsqrtf(sum * (1.0f / 1024.0f) + 1e-6f); } } \
            __syncthreads(); } \
          pg8::EpiZ E{Z + (COL0), rsl, pml, DIN}; \
          pg8::gemm_phase<pg8::EpiZ, pg8::StaticOrder, true, true>(lds, g, S, E); } while (0)
        unsigned* xbr = (unsigned*)(a.ws + WS_BAR) + 3584;
#pragma unroll 1
        for (int part = 0; part < 2; ++part) {
            const int ncols = part ? 512 : 4096, col0 = part ? 4096 : 0;
            if (part == 0 || G != 256 || bid < 128) PA_PART(ncols, col0);
            if (part == (G == 256 ? 0 : 1)) xcd_barrier(xbar);
            if (part == 1 && G == 256 && bid < 128) { __syncthreads(); if (threadIdx.x == 0) (void)__hip_atomic_fetch_add(xbr, 1u, __ATOMIC_RELAXED, __HIP_MEMORY_SCOPE_AGENT); }
        }
        for (int it = 0; ; ++it) { int u;
            if (G == 256) { if (bid >= 128) { u = it < 2 ? 768 + bid + it * 256 : (it == 2 ? 2000 : (it < 7 ? (bid - 128) + (it - 3) * 128 : (it == 7 ? 2001 : 3000))); }
                            else { u = it < 2 ? 512 + bid + it * 128 : (it < 5 ? 768 + bid + (it - 2) * 256 : (it == 5 ? 2000 : (it == 6 ? 2001 : 3000))); } }
            else { u = bid + it * G; if (u >= 1408) { const int over = (u - 1408) / G; u = over == 0 ? 2000 : (over == 1 ? 2001 : 3000); } }
            if (u >= 3000) break;
            __syncthreads();
            if (u >= 2000) {
                int tid_ = threadIdx.x; asm volatile("" : "+v"(tid_)); const int lane = tid_ & 63, wid = tid_ >> 6, gw = bid * 8 + wid;
                LAS float* scr = (LAS float*)(lds + wid * 8448);
                if (u == 2000) transpose_wout(a, l, scr, NGW - 1 - gw, NGW, lane);
                else if (l + 1 < DEPTH) {
                    if (G == 256) { if (tid_ == 0) { unsigned sp = 0; while (__hip_atomic_load(xbr, __ATOMIC_RELAXED, __HIP_MEMORY_SCOPE_AGENT) < 128u * (unsigned)(l + 1)) { __builtin_amdgcn_s_sleep(2); if (++sp > (1u << 22)) break; } } __syncthreads(); }
                    transpose_win(a, l + 1, scr, gw, NGW, lane); }
                continue; }
#ifndef NO_LRU
            if (u < 768) { const int k = u % 6, c = (u / 6) % NCHUNK, b = u / (6 * NCHUNK); for (int rep = 0; rep < REP_LRU; ++rep) { lru_tile(a, l, b, c, k, lds, xbr, (G == 256 && it == (bid >= 128 ? 3 : 0)) ? 128u * (unsigned)(l + 1) : 0u); __syncthreads(); } }
#endif
#ifndef NO_POOL
            if (u >= 768 && u < 1280) { const int v = u - 768; for (int rep = 0; rep < REP_POOL; ++rep) { pool_tile(a, l, v >> 8, (v >> 2) & 63, v & 3, lds); __syncthreads(); } }
#endif
#ifndef NO_ROPE
#ifdef REP_DRY
            if (u >= 1280) {
#pragma unroll 1
              for (int rep = 0; rep < 2; ++rep) rope_unit(a, l, u - 1280, rep == 1 || a.inv[31] < 0.f); }
#else
            if (u >= 1280) rope_unit(a, l, u - 1280);
#endif
#endif
        }
        xcd_barrier(xbar);
#ifndef NOMAX_BOUND
#define NOMAX_BOUND 30.f
#endif
        bool nomax;
        { int tid_ = threadIdx.x; asm volatile("" : "+v"(tid_)); const int ln = tid_ & 63;
          float mq = fmaxf(fabsf(a.in[12][l * 128 + ln]), fabsf(a.in[12][l * 128 + 64 + ln])), mk = fmaxf(fabsf(a.in[13][l * 128 + ln]), fabsf(a.in[13][l * 128 + 64 + ln]));
#pragma unroll
          for (int o = 1; o < 64; o <<= 1) { mq = fmaxf(mq, __shfl_xor(mq, o)); mk = fmaxf(mk, __shfl_xor(mk, o)); }
          nomax = 11.3137085f * 1.02f * mq * mk < NOMAX_BOUND; }
#define ATT_CALL(MODE, ...) do { if (nomax) att::attn_dense_body<att::bf16, MODE, true>(__VA_ARGS__); else att::attn_dense_body<att::bf16, MODE, false>(__VA_ARGS__); } while (0)
        if (G == 256) {
            const int xcd = bid & 7, slot = bid >> 3, grp = xcd >> 1, b = grp >> 1, kvh = grp & 1, base = 48 * (xcd & 1);
            const size_t krow = (size_t)b * SEQL;
            { const int j = base + slot, h = kvh * 3 + (j >> 5), qb = j & 31; const size_t qrow = krow + qb * 256;
              for (int rep = 0; rep < REP_ATT; ++rep) {
              __syncthreads();
              ATT_CALL(0, Z + qrow * DIN + C_Q + h * 128, Z + krow * DIN + C_K + kvh * 128, Z + krow * DIN + C_V + kvh * 128,
                                                 Z + qrow * DIN + C_GATT + h * 128, Y + qrow * DMIX + Y_ATT + h * 128, DMIX, nullptr, SEQL, (char*)lds_raw, a.in[12] + l * 128, (const float*)(a.ws + WS_ROPE), qb * 256); } }
            { const int j = base + 32 + (slot >> 1), half = slot & 1, sidx = xcd * 16 + (slot >> 1), h = kvh * 3 + (j >> 5), qb = j & 31; const size_t qrow = krow + qb * 256, k0 = krow + (size_t)half * (SEQL / 2);
              bf16_t* po = half == 0 ? Y + qrow * DMIX + Y_ATT + h * 128 : (bf16_t*)(a.ws + WS_PART) + (size_t)sidx * 256 * 128;
              for (int rep = 0; rep < REP_ATTH; ++rep) {
              __syncthreads();
              ATT_CALL(1, Z + qrow * DIN + C_Q + h * 128, Z + k0 * DIN + C_K + kvh * 128, Z + k0 * DIN + C_V + kvh * 128,
                                                 nullptr, po, half == 0 ? DMIX : 128, (float*)(a.ws + WS_LSE) + ((size_t)sidx * 2 + half) * 256, SEQL / 2, (char*)lds_raw, a.in[12] + l * 128, (const float*)(a.ws + WS_ROPE), qb * 256); } }
#ifdef REP_DRY
#pragma unroll 1
            for (int rep = 0; rep < 2; ++rep) fixup_unit(a, bid, lds, rep == 1 || a.inv[31] < 0.f);
#else
            fixup_unit(a, bid, lds);
#endif
            xcd_barrier(xbar);
            {
                const int sidx = bid >> 1, rh = bid & 1, sx = sidx >> 4, sgrp = sx >> 1, sb = sgrp >> 1, skvh = sgrp & 1, j = 48 * (sx & 1) + 32 + (sidx & 15), h = skvh * 3 + (j >> 5), qb = j & 31;
                const size_t qrow = (size_t)sb * SEQL + qb * 256 + rh * 128;
                const bf16_t* p2 = (const bf16_t*)(a.ws + WS_PART) + (size_t)sidx * 256 * 128 + (size_t)rh * 128 * 128; const float* lse = (const float*)(a.ws + WS_LSE) + (size_t)sidx * 512 + rh * 128;
                int tid_ = threadIdx.x; asm volatile("" : "+v"(tid_));
                u32x4 o1v[4], o2v[4], gv[4]; float l1v[4], l2v[4];
#pragma unroll
                for (int i = 0; i < 4; ++i) { const int idx = tid_ + i * 512, row = idx >> 4, ck = idx & 15;
                    o1v[i] = *(const u32x4*)(Y + (qrow + row) * DMIX + Y_ATT + h * 128 + ck * 8); o2v[i] = *(const u32x4*)(p2 + row * 128 + ck * 8);
                    gv[i] = *(const u32x4*)(Z + (qrow + row) * DIN + C_GATT + h * 128 + ck * 8); l1v[i] = lse[row]; l2v[i] = lse[256 + row]; }
#pragma unroll
                for (int i = 0; i < 4; ++i) { const int idx = tid_ + i * 512, row = idx >> 4, ck = idx & 15;
                    bf16_t* yp = Y + (qrow + row) * DMIX + Y_ATT + h * 128 + ck * 8;
                    const u32x4 o1 = o1v[i], o2 = o2v[i], g = gv[i];
                    const float l1 = l1v[i], l2 = l2v[i], w1 = __builtin_amdgcn_rcpf(1.f + __expf(l2 - l1)), w2 = 1.f - w1;
                    u32x4 r;
#pragma unroll
                    for (int e = 0; e < 4; ++e) r[e] = pk2((w1 * bflo(o1[e]) + w2 * bflo(o2[e])) * silu_f(bflo(g[e])), (w1 * bfhi(o1[e]) + w2 * bfhi(o2[e])) * silu_f(bfhi(g[e])));
                    *(u32x4*)yp = r; }
            }
        } else {
            for (int ul = bid; ul < 384; ul += G) { const int grp = ul / 96, j = ul % 96, b = grp >> 1, kvh = grp & 1, h = kvh * 3 + (j >> 5), qb = j & 31;
                const size_t qrow = (size_t)b * SEQL + qb * 256, krow = (size_t)b * SEQL;
                __syncthreads();
                ATT_CALL(0, Z + qrow * DIN + C_Q + h * 128, Z + krow * DIN + C_K + kvh * 128, Z + krow * DIN + C_V + kvh * 128,
                                                   Z + qrow * DIN + C_GATT + h * 128, Y + qrow * DMIX + Y_ATT + h * 128, DMIX, nullptr, SEQL, (char*)lds_raw, a.in[12] + l * 128, (const float*)(a.ws + WS_ROPE), qb * 256); }
            for (int f = bid; f < 256; f += G) fixup_unit(a, f, lds);
        }
        xcd_barrier(xbar);
#ifndef NO_D
        { pg8::Gemm g{Y, (const bf16_t*)(a.ws + WS_WOUT), M, DM, DMIX}; pg8::StaticOrder S; S.init(M, DM, G, bid);
          pg8::EpiRes E{l == 0 ? a.in[0] : a.out, a.out, XB, ssq};
#ifdef REP_D
          { pg8::EpiRes E2{l == 0 ? a.in[0] : a.out, (float*)(a.ws + WS_Z), XB, ssq}; pg8::gemm_phase<pg8::EpiRes, pg8::StaticOrder, true, true>(lds, g, S, E2); }
#endif
          pg8::gemm_phase<pg8::EpiRes, pg8::StaticOrder, true, true>(lds, g, S, E); }
#endif
        if (l + 1 < DEPTH) xcd_barrier(xbar);
    }
}

extern "C" void kernel_launch(void* const* d_in, const int* in_sizes, int n_in, void* d_out, int out_size,
                              void* d_ws, size_t ws_size, hipStream_t stream) {
    static int grid_blocks = 0;
    if (!grid_blocks) {
        int dev = 0, cus = 0, per_cu = 0;
        (void)hipGetDevice(&dev);
        (void)hipDeviceGetAttribute(&cus, hipDeviceAttributeMultiprocessorCount, dev);
        (void)hipFuncSetAttribute((const void*)mega, hipFuncAttributeMaxDynamicSharedMemorySize, LDS_BYTES);
        (void)hipOccupancyMaxActiveBlocksPerMultiprocessor(&per_cu, (const void*)mega, 512, LDS_BYTES);
        if (per_cu < 1) per_cu = 1;
        grid_blocks = cus * per_cu;
        if (ws_size < WS_END) fprintf(stderr, "kernel_launch: workspace too small: %zu < %zu\n", ws_size, (size_t)WS_END);
    }
    Args a{};
    for (int i = 0; i < 15 && i < n_in; ++i) a.in[i] = (const float*)d_in[i];
    a.out = (float*)d_out; a.ws = (unsigned char*)d_ws;
    for (int i = 0; i < 32; ++i) a.inv[i] = (float)std::pow(10000.0, -(double)(2 * i) / 64.0);
    (void)hipMemsetAsync((unsigned char*)d_ws + WS_BAR, 0, 16384, stream);
    void* args[] = {&a};
    hipError_t e = hipLaunchCooperativeKernel((const void*)mega, dim3(grid_blocks), dim3(512), args, LDS_BYTES, stream);
    if (e != hipSuccess) fprintf(stderr, "cooperative launch failed: %s (grid %d)\n", hipGetErrorString(e), grid_blocks);
}
```

```cpp
#include <hip/hip_runtime.h>
#include <hip/hip_cooperative_groups.h>
#include <cstdio>
#include <cstdint>
#include <cmath>
namespace cg = cooperative_groups;

namespace pg8 {
#define PG8_LAS __attribute__((address_space(3)))
typedef unsigned short bf16_t;
typedef short bf16x8 __attribute__((ext_vector_type(8)));
typedef float f32x4 __attribute__((ext_vector_type(4)));
typedef unsigned u32x4 __attribute__((ext_vector_type(4)));
constexpr int BM = 256, BK = 64, HALF = 128, HTB = HALF * BK * 2  , STAGE_BYTES = 8 * HTB, NXCD = 8, WGM = 8;

__host__ __device__ __forceinline__ int lds_byte(int r, int c) { const int st = (r >> 4) * 2 + (c >> 5), rr = r & 15, cc = c & 31, ob = rr * 64 + cc * 2; return st * 1024 + (ob ^ (((ob >> 9) & 1) << 5)); }
__host__ __device__ __forceinline__ void stage_rc(int b, int& R, int& C) { const int st = b / 1024, sb = b % 1024, swz = sb ^ (((sb >> 9) & 1) << 5); R = (st >> 1) * 16 + swz / 64; C = (st & 1) * 32 + (swz % 64) / 2; }
__host__ __device__ __forceinline__ int perm32(int rho) { const int n = rho >> 4, i = rho & 15; return 8 * (i >> 2) + 4 * n + (i & 3); }

struct Unit { int pm, pn; };
struct Gemm { const bf16_t* A; const bf16_t* Bt; int M, N, K; };

struct StaticOrder {
    int nM, nN, nwg, G, c;
    __host__ __device__ void init(int M, int N, int G_, int c_) { nM = M / BM; nN = N / BM; nwg = nM * nN; G = G_; c = c_; }
    __host__ __device__ bool next(int i, Unit& u) const {
        const long L = (long)i * G + c; if (L >= nwg) return false;
        int wgid = (int)L; { const int q = nwg / NXCD, r = nwg % NXCD, xcd = wgid % NXCD, off = wgid / NXCD; wgid = (xcd < r ? xcd * (q + 1) : r * (q + 1) + (xcd - r) * q) + off; }
        const int nig = WGM * nN, gid = wgid / nig, fm = gid * WGM, gsz = (nM - fm) < WGM ? (nM - fm) : WGM;
        u.pm = fm + ((wgid % nig) % gsz); u.pn = (wgid % nig) / gsz; return true;
    }
    __device__ __forceinline__ void a_ready(const Unit&) const {}
    __device__ __forceinline__ void done(const Unit&) const {}
};

__device__ __forceinline__ unsigned cvt_pk_bf16(float lo, float hi) { unsigned r; asm volatile("v_cvt_pk_bf16_f32 %0, %1, %2" : "=v"(r) : "v"(lo), "v"(hi)); return r; }

struct EpiZ {
    static constexpr bool PERM = true, AFTER_DRAIN = false;
    bf16_t* Z; const PG8_LAS float* rsl; const PG8_LAS int* pml; int ldz;
    __device__ __forceinline__ void operator()(const f32x4 (&acc)[2][2][4][2], const Unit& u, int wr, int wc, int fr, int fq) const {
        const int row0 = u.pm * BM + wr * 64 + fr, col0 = u.pn * BM + wc * 32 + 8 * fq;
        int slot = 0;
#pragma unroll
        for (int i = 1; i < 8; ++i) slot = (pml[i] == u.pm) ? i : slot;
        const PG8_LAS float* rp = rsl + slot * 256 + wr * 64 + fr;
#pragma unroll
        for (int ai = 0; ai < 2; ++ai)
#pragma unroll
            for (int m = 0; m < 4; ++m) { const int row = row0 + ai * HALF + m * 16;
                const float rs = rp[ai * HALF + m * 16];
                bf16_t* rowp = Z + (size_t)row * ldz + col0;
#pragma unroll
                for (int bj = 0; bj < 2; ++bj) { const f32x4 v0 = acc[ai][bj][m][0] * rs, v1 = acc[ai][bj][m][1] * rs;
                    u32x4 w; w.x = cvt_pk_bf16(v0[0], v0[1]); w.y = cvt_pk_bf16(v0[2], v0[3]); w.z = cvt_pk_bf16(v1[0], v1[1]); w.w = cvt_pk_bf16(v1[2], v1[3]);
                    *(u32x4*)(rowp + bj * HALF) = w; } }
    }
};
struct EpiRes {
    static constexpr bool PERM = true, AFTER_DRAIN = false;
    const float* xin; float* out; bf16_t* XB; float* ssq;
    __device__ __forceinline__ void operator()(const f32x4 (&acc)[2][2][4][2], const Unit& u, int wr, int wc, int fr, int fq) const {
        const int row0 = u.pm * BM + wr * 64 + fr, col0 = u.pn * BM + wc * 32 + 8 * fq;
#pragma unroll
        for (int ai = 0; ai < 2; ++ai) {
            f32x4 xa[4][2][2];
#pragma unroll
            for (int m = 0; m < 4; ++m)
#pragma unroll
                for (int bj = 0; bj < 2; ++bj) { const size_t off = (size_t)(row0 + ai * HALF + m * 16) * 1024 + col0 + bj * HALF;
                    xa[m][bj][0] = *(const f32x4*)(xin + off); xa[m][bj][1] = *(const f32x4*)(xin + off + 4); }
#pragma unroll
            for (int m = 0; m < 4; ++m) { const int row = row0 + ai * HALF + m * 16; float q = 0.f;
#pragma unroll
                for (int bj = 0; bj < 2; ++bj) { const size_t off = (size_t)row * 1024 + col0 + bj * HALF;
                    const f32x4 v0 = acc[ai][bj][m][0] + xa[m][bj][0], v1 = acc[ai][bj][m][1] + xa[m][bj][1];
                    *(f32x4*)(out + off) = v0; *(f32x4*)(out + off + 4) = v1;
                    q += (v0[0] * v0[0] + v0[1] * v0[1]) + (v0[2] * v0[2] + v0[3] * v0[3]) + (v1[0] * v1[0] + v1[1] * v1[1]) + (v1[2] * v1[2] + v1[3] * v1[3]);
                    u32x4 w; w.x = cvt_pk_bf16(v0[0], v0[1]); w.y = cvt_pk_bf16(v0[2], v0[3]); w.z = cvt_pk_bf16(v1[0], v1[1]); w.w = cvt_pk_bf16(v1[2], v1[3]);
                    *(u32x4*)(XB + off) = w; }
                q += __shfl_xor(q, 16); q += __shfl_xor(q, 32);
                if (fq == 0) ssq[(size_t)row * 16 + u.pn * 4 + wc] = q; } }
    }
};

template <class Epi, class Sched, bool ALIGN_EPI = false, bool SP2 = false>
__device__ __forceinline__ void gemm_phase(PG8_LAS unsigned char* lds, const Gemm g, const Sched& S, const Epi& E) {
    int tid_ = threadIdx.x; asm volatile("" : "+v"(tid_));
    const int tid = tid_, wid = __builtin_amdgcn_readfirstlane(tid >> 6), lane = tid & 63, wr = wid >> 2, wc = wid & 3, fr = lane & 15, fq = lane >> 4;
    const int K = g.K, nt = K / BK;
    unsigned voffA[2], voffB[2];
#pragma unroll
    for (int i = 0; i < 2; ++i) { int R, C; stage_rc(tid * 16 + i * 8192, R, C); const int Rb = Epi::PERM ? ((R & ~31) + perm32(R & 31)) : R;
        voffA[i] = (unsigned)(R * K + C) * 2u; voffB[i] = (unsigned)(Rb * K + C) * 2u; }
    const size_t kstep = (size_t)(BK * 2);
    const size_t hstep = (size_t)HALF * K * 2;
    const size_t tstep = 2 * hstep;
    const unsigned ldsw = (unsigned)wid * 1024u;
    const int aoff = lds_byte(wr * 64 + fr, fq * 8), boff = lds_byte(wc * 32 + fr, fq * 8);
#define PG8_SA(b, h) (((b) * 2 + (h)) * HTB)
#define PG8_SB(b, h) ((4 + (b) * 2 + (h)) * HTB)
#define PG8_STAGE(bufoff, gbase, voff) do { _Pragma("unroll") for (int _i = 0; _i < 2; ++_i) \
        __builtin_amdgcn_global_load_lds((const unsigned*)((const char*)(gbase) + (voff)[_i]), (PG8_LAS unsigned*)(lds + (bufoff) + ldsw + _i * 8192), 16, 0, 0); } while (0)
#define PG8_LDA(dst, b, h) do { _Pragma("unroll") for (int m = 0; m < 4; ++m) _Pragma("unroll") for (int k = 0; k < 2; ++k) dst[m][k] = *(const PG8_LAS bf16x8*)(lds + PG8_SA(b, h) + aoff + m * 2048 + k * 1024); } while (0)
#define PG8_LDB(dst, b, h) do { _Pragma("unroll") for (int n = 0; n < 2; ++n) _Pragma("unroll") for (int k = 0; k < 2; ++k) dst[n][k] = *(const PG8_LAS bf16x8*)(lds + PG8_SB(b, h) + boff + n * 2048 + k * 1024); } while (0)
#define PG8_MMA(ai, bj, At, Bt) do { __builtin_amdgcn_s_setprio(1); _Pragma("unroll") for (int m = 0; m < 4; ++m) _Pragma("unroll") for (int n = 0; n < 2; ++n) _Pragma("unroll") for (int k = 0; k < 2; ++k) \
        acc[ai][bj][m][n] = __builtin_amdgcn_mfma_f32_16x16x32_bf16(Bt[n][k], At[m][k], acc[ai][bj][m][n], 0, 0, 0); __builtin_amdgcn_s_setprio(0); } while (0)
#define PG8_WAIT_V(n) asm volatile("s_waitcnt vmcnt(" #n ")" ::: "memory")
#define PG8_WAIT_L(n) asm volatile("s_waitcnt lgkmcnt(" #n ")" ::: "memory")
#define PG8_BAR __builtin_amdgcn_s_barrier()
#define PG8_SCHED __builtin_amdgcn_sched_barrier(0)
    Unit cur, nxt; int ui = 0;
    if (!S.next(0, cur)) return;
    f32x4 acc[2][2][4][2];
#pragma unroll
    for (int a = 0; a < 2; ++a)
#pragma unroll
        for (int b = 0; b < 2; ++b)
#pragma unroll
            for (int m = 0; m < 4; ++m)
#pragma unroll
                for (int n = 0; n < 2; ++n) acc[a][b][m][n] = (f32x4){0.f, 0.f, 0.f, 0.f};
    bf16x8 At[4][2], B0[2][2], B1[2][2];
    const char* cA = (const char*)g.A + (size_t)cur.pm * tstep; const char* cB = (const char*)g.Bt + (size_t)cur.pn * tstep;
    S.a_ready(cur);
    if constexpr (SP2) {
        PG8_STAGE(PG8_SB(0, 0), cB, voffB); PG8_STAGE(PG8_SB(0, 1), cB + hstep, voffB); PG8_STAGE(PG8_SA(0, 0), cA, voffA); PG8_STAGE(PG8_SA(0, 1), cA + hstep, voffA);
        if (wr == 1) PG8_BAR;
        PG8_WAIT_V(2); PG8_BAR;
        PG8_STAGE(PG8_SB(1, 0), cB + kstep, voffB); PG8_STAGE(PG8_SA(1, 0), cA + kstep, voffA); PG8_STAGE(PG8_SB(1, 1), cB + hstep + kstep, voffB);
        PG8_WAIT_V(6); PG8_BAR;
    } else {
        PG8_STAGE(PG8_SB(0, 0), cB, voffB); PG8_STAGE(PG8_SA(0, 0), cA, voffA); PG8_STAGE(PG8_SB(0, 1), cB + hstep, voffB); PG8_STAGE(PG8_SA(0, 1), cA + hstep, voffA);
        if (wr == 1) PG8_BAR;
        PG8_WAIT_V(4); PG8_BAR;
        PG8_STAGE(PG8_SB(1, 0), cB + kstep, voffB); PG8_STAGE(PG8_SA(1, 0), cA + kstep, voffA); PG8_STAGE(PG8_SB(1, 1), cB + hstep + kstep, voffB);
        PG8_WAIT_V(6); PG8_BAR;
    }
    for (;;) {
        const bool has_next = S.next(ui + 1, nxt);
        const char* nA = has_next ? (const char*)g.A + (size_t)nxt.pm * tstep : cA; const char* nB = has_next ? (const char*)g.Bt + (size_t)nxt.pn * tstep : cB;
        for (int t = 0; t < nt; t += 2) {
            const bool last = (t == nt - 2);
            const char* a1 = cA + (size_t)(t + 1) * kstep;
            const char* a2 = last ? nA : cA + (size_t)(t + 2) * kstep; const char* b2 = last ? nB : cB + (size_t)(t + 2) * kstep;
            const char* a3 = a2 + kstep; const char* b3 = b2 + kstep;
            if (last && has_next) S.a_ready(nxt);
            if constexpr (SP2) {
            PG8_LDB(B0, 0, 0); PG8_LDB(B1, 0, 1); PG8_SCHED; PG8_LDA(At, 0, 0); PG8_STAGE(PG8_SA(1, 1), a1 + hstep, voffA);
            PG8_WAIT_V(8); PG8_WAIT_L(0); PG8_BAR; PG8_MMA(0, 0, At, B0); PG8_MMA(0, 1, At, B1); PG8_BAR; PG8_SCHED;
            PG8_LDA(At, 0, 1); PG8_STAGE(PG8_SB(0, 0), b2, voffB); PG8_STAGE(PG8_SB(0, 1), b2 + hstep, voffB); PG8_STAGE(PG8_SA(0, 0), a2, voffA);
            PG8_WAIT_V(8); PG8_WAIT_L(0); PG8_BAR; PG8_MMA(1, 0, At, B0); PG8_MMA(1, 1, At, B1); PG8_BAR; PG8_SCHED;
            PG8_LDB(B0, 1, 0); PG8_LDB(B1, 1, 1); PG8_SCHED; PG8_LDA(At, 1, 0); PG8_STAGE(PG8_SA(0, 1), a2 + hstep, voffA);
            PG8_WAIT_V(8); PG8_WAIT_L(0); PG8_BAR; PG8_MMA(0, 0, At, B0); PG8_MMA(0, 1, At, B1); PG8_BAR; PG8_SCHED;
            PG8_LDA(At, 1, 1); PG8_STAGE(PG8_SB(1, 0), b3, voffB); PG8_STAGE(PG8_SB(1, 1), b3 + hstep, voffB); PG8_STAGE(PG8_SA(1, 0), a3, voffA);
            PG8_WAIT_V(8); PG8_WAIT_L(0); PG8_BAR; PG8_MMA(1, 0, At, B0); PG8_MMA(1, 1, At, B1); PG8_BAR; PG8_SCHED;
            } else {
            PG8_LDB(B0, 0, 0); PG8_SCHED; PG8_LDA(At, 0, 0); PG8_STAGE(PG8_SA(1, 1), a1 + hstep, voffA);
            PG8_WAIT_L(8); PG8_BAR; PG8_WAIT_L(0); PG8_MMA(0, 0, At, B0); PG8_BAR; PG8_SCHED;
            PG8_LDB(B1, 0, 1); PG8_STAGE(PG8_SB(0, 0), b2, voffB);
            PG8_BAR; PG8_WAIT_L(0); PG8_MMA(0, 1, At, B1); PG8_BAR;
            PG8_LDA(At, 0, 1); PG8_STAGE(PG8_SA(0, 0), a2, voffA);
            PG8_BAR; PG8_WAIT_L(0); PG8_MMA(1, 0, At, B0); PG8_BAR; PG8_SCHED;
            PG8_STAGE(PG8_SB(0, 1), b2 + hstep, voffB);
            PG8_WAIT_V(6); PG8_BAR; PG8_MMA(1, 1, At, B1); PG8_BAR;
            PG8_LDB(B0, 1, 0); PG8_SCHED; PG8_LDA(At, 1, 0); PG8_STAGE(PG8_SA(0, 1), a2 + hstep, voffA);
            PG8_WAIT_L(8); PG8_BAR; PG8_WAIT_L(0); PG8_MMA(0, 0, At, B0); PG8_BAR; PG8_SCHED;
            PG8_LDB(B1, 1, 1); PG8_STAGE(PG8_SB(1, 0), b3, voffB);
            PG8_BAR; PG8_WAIT_L(0); PG8_MMA(0, 1, At, B1); PG8_BAR;
            PG8_LDA(At, 1, 1); PG8_STAGE(PG8_SA(1, 0), a3, voffA);
            PG8_BAR; PG8_WAIT_L(0); PG8_MMA(1, 0, At, B0); PG8_BAR; PG8_SCHED;
            PG8_STAGE(PG8_SB(1, 1), b3 + hstep, voffB);
            PG8_WAIT_V(6); PG8_BAR; PG8_MMA(1, 1, At, B1); PG8_BAR;
            }
        }
        if constexpr (ALIGN_EPI) { if (wr == 0) PG8_BAR; }
        if constexpr (!Epi::AFTER_DRAIN) { E(acc, cur, wr, wc, fr, fq); S.done(cur); }
        if (!has_next) break;
#pragma unroll
        for (int a = 0; a < 2; ++a)
#pragma unroll
            for (int b = 0; b < 2; ++b)
#pragma unroll
                for (int m = 0; m < 4; ++m)
#pragma unroll
                    for (int n = 0; n < 2; ++n) acc[a][b][m][n] = (f32x4){0.f, 0.f, 0.f, 0.f};
        cur = nxt; cA = nA; cB = nB; ++ui;
        if constexpr (ALIGN_EPI) { if (wr == 1) PG8_BAR; }
    }
    PG8_WAIT_V(0);
    if constexpr (!ALIGN_EPI) { if (wr == 0) PG8_BAR; }
    PG8_BAR;
    if constexpr (Epi::AFTER_DRAIN) { E.fused(acc, cur, wr, wc, fr, fq, lds, wid, lane); S.done(cur); }
#undef PG8_SA
#undef PG8_SB
#undef PG8_STAGE
#undef PG8_LDA
#undef PG8_LDB
#undef PG8_MMA
#undef PG8_WAIT_V
#undef PG8_WAIT_L
#undef PG8_BAR
#undef PG8_SCHED
}
}
namespace att {
typedef unsigned short bf16;
constexpr int   D = 128, NW = 8, QBLK = 32, KVBLK = 64;
constexpr float SCALE = 0.088388347648318440f;
constexpr float THR = 8.f;
constexpr int SDEPTH = 2;
constexpr int LDQ = 4608, LDK = 4608, LDG = 4608, LDO = 2048;
constexpr size_t SHM_V = KVBLK * D * 2, SHM_K = KVBLK * D * 2, SHM_ATTN = 3 * SHM_V + 3 * SHM_K + NW * 64 * 4;
using bf16x8 = __attribute__((ext_vector_type(8))) short;
using s16x4  = __attribute__((ext_vector_type(4))) short;
using f32x16 = __attribute__((ext_vector_type(16))) float;
using f32x8  = __attribute__((ext_vector_type(8))) float;
using u32x4  = __attribute__((ext_vector_type(4))) unsigned;
#define KSWZ(row, colB) ((row) * 256 + ((colB) ^ (((row) & 7) << 4)))
#undef SBAR
#define SBAR() __builtin_amdgcn_sched_barrier(0)
__device__ __forceinline__ int crow(int r, int hi) { return (r & 3) + 8 * (r >> 2) + 4 * hi; }
__device__ __forceinline__ unsigned cvtpk(float lo, float hi) {
  unsigned r; asm volatile("v_cvt_pk_bf16_f32 %0, %1, %2" : "=v"(r) : "v"(lo), "v"(hi)); return r;
}
template <typename TIn> struct Stage;
template <> struct Stage<bf16>  { using T = bf16x8;
  __device__ static __forceinline__ T ld8(const bf16* p) { return *reinterpret_cast<const bf16x8*>(p); }
  __device__ static __forceinline__ bf16x8 tobf(T x) { return x; } };
template <> struct Stage<float> { using T = f32x8;
  __device__ static __forceinline__ T ld8(const float* p) { return *reinterpret_cast<const f32x8*>(p); }
  __device__ static __forceinline__ bf16x8 tobf(T x) {
    u32x4 w = {cvtpk(x[0], x[1]), cvtpk(x[2], x[3]), cvtpk(x[4], x[5]), cvtpk(x[6], x[7])}; return *reinterpret_cast<bf16x8*>(&w); } };

template <bool NOMAX>
__device__ __forceinline__ void partialSM(f32x16& p0, f32x16& p1, float& m_reg, float& mn, float& alpha) {
  if constexpr (NOMAX) { mn = 0.f; alpha = 1.f; for (int r = 0; r < 16; ++r) p0[r] = __builtin_amdgcn_exp2f(p0[r]); return; }
  constexpr float C = SCALE * 1.4426950408889634f;
  float pmax = p0[0]; for (int r = 1; r < 16; ++r) pmax = fmaxf(pmax, p0[r]); for (int r = 0; r < 16; ++r) pmax = fmaxf(pmax, p1[r]);
  { auto rr = __builtin_amdgcn_permlane32_swap(__float_as_uint(pmax), __float_as_uint(pmax), false, false);
    pmax = fmaxf(__uint_as_float(rr[0]), __uint_as_float(rr[1])); }
  if (__builtin_expect(__all(pmax - m_reg <= THR / SCALE), 1)) { mn = m_reg; alpha = 1.f; }
  else { mn = fmaxf(m_reg, pmax); alpha = __builtin_amdgcn_exp2f((m_reg - mn) * C); m_reg = mn; }
  float mnC = -mn * C;
  for (int r = 0; r < 16; ++r) p0[r] = fmaf(p0[r], C, mnC); for (int r = 0; r < 16; ++r) p1[r] = fmaf(p1[r], C, mnC);
  for (int r = 0; r < 16; ++r) p0[r] = __builtin_amdgcn_exp2f(p0[r]);
}
__device__ __forceinline__ void finishSM(f32x16& p0, f32x16& p1, float alpha, float& l_reg, bf16x8& pa0, bf16x8& pa1, bf16x8& pa2, bf16x8& pa3) {
  for (int r = 0; r < 16; ++r) p1[r] = __builtin_amdgcn_exp2f(p1[r]);
  float ps = 0; for (int r = 0; r < 16; ++r) ps += p0[r]; for (int r = 0; r < 16; ++r) ps += p1[r];
  { auto rr = __builtin_amdgcn_permlane32_swap(__float_as_uint(ps), __float_as_uint(ps), false, false);
    ps = __uint_as_float(rr[0]) + __uint_as_float(rr[1]); }
  l_reg = l_reg * alpha + ps;
#define PK8(P, BASE, OUT) do { u32x4 w = {cvtpk(P[BASE + 0], P[BASE + 1]), cvtpk(P[BASE + 2], P[BASE + 3]), cvtpk(P[BASE + 4], P[BASE + 5]), cvtpk(P[BASE + 6], P[BASE + 7])}; \
    OUT = *reinterpret_cast<bf16x8*>(&w); } while (0)
  PK8(p0, 0, pa0); PK8(p0, 8, pa1); PK8(p1, 0, pa2); PK8(p1, 8, pa3);
#undef PK8
}
__device__ __forceinline__ void qkt(f32x16& p0, f32x16& p1, const bf16* Ks, const bf16x8* qr, int r32, int hi) {
  p0 = f32x16{}; p1 = f32x16{};
  for (int d0 = 0; d0 < 8; ++d0) { int cb = (d0 * 16 + hi * 8) * 2;
    bf16x8 b0 = *reinterpret_cast<const bf16x8*>((const char*)Ks + KSWZ(r32, cb));
    bf16x8 b1 = *reinterpret_cast<const bf16x8*>((const char*)Ks + KSWZ(32 + r32, cb));
    p0 = __builtin_amdgcn_mfma_f32_32x32x16_bf16(b0, qr[d0], p0, 0, 0, 0);
    p1 = __builtin_amdgcn_mfma_f32_32x32x16_bf16(b1, qr[d0], p1, 0, 0, 0); }
}
__device__ __forceinline__ int v_st(int k, int c) { const int kk = (k & ~0xC) | ((k & 4) << 1) | ((k & 8) >> 1); return ((kk >> 3) * 4 + (c >> 5)) * 512 + ((kk & 7) * 32 + (c & 31)) * 2; }
__device__ __forceinline__ int v_rd_base(int lane) { return ((lane & 3) << 3) | (((lane >> 2) & 3) << 6) | (((lane >> 4) & 1) << 5) | (((lane >> 5) & 1) << 11); }
constexpr int v_rd_off(int d0, int ks, int half) { return d0 * 512 + ks * 4096 + half * 256; }
template <int OFF> __device__ __forceinline__ s16x4 tr_read(int vb) {
  s16x4 r; asm volatile("ds_read_b64_tr_b16 %0, %1 offset:%2" : "=&v"(r) : "v"(vb), "i"(OFF) : "memory"); return r;
}
struct VF { s16x4 l0, h0, l1, h1, l2, h2, l3, h3; };
template <int D0> __device__ __forceinline__ void pv_rd(VF& f, int vb) {
  f.l0 = tr_read<v_rd_off(D0, 0, 0)>(vb); f.h0 = tr_read<v_rd_off(D0, 0, 1)>(vb); f.l1 = tr_read<v_rd_off(D0, 1, 0)>(vb); f.h1 = tr_read<v_rd_off(D0, 1, 1)>(vb);
  f.l2 = tr_read<v_rd_off(D0, 2, 0)>(vb); f.h2 = tr_read<v_rd_off(D0, 2, 1)>(vb); f.l3 = tr_read<v_rd_off(D0, 3, 0)>(vb); f.h3 = tr_read<v_rd_off(D0, 3, 1)>(vb);
}
__device__ __forceinline__ void pv_mm(f32x16& od, const VF& f, bf16x8 pa0, bf16x8 pa1, bf16x8 pa2, bf16x8 pa3) {
#define PK(L, H) (bf16x8){L[0], L[1], L[2], L[3], H[0], H[1], H[2], H[3]}
  od = __builtin_amdgcn_mfma_f32_32x32x16_bf16(pa0, PK(f.l0, f.h0), od, 0, 0, 0);
  od = __builtin_amdgcn_mfma_f32_32x32x16_bf16(pa1, PK(f.l1, f.h1), od, 0, 0, 0);
  od = __builtin_amdgcn_mfma_f32_32x32x16_bf16(pa2, PK(f.l2, f.h2), od, 0, 0, 0);
  od = __builtin_amdgcn_mfma_f32_32x32x16_bf16(pa3, PK(f.l3, f.h3), od, 0, 0, 0);
#undef PK
}
__device__ __forceinline__ void pv_d0(f32x16* o, int vb, bf16x8 pa0, bf16x8 pa1, bf16x8 pa2, bf16x8 pa3) {
  VF fa, fb;
  pv_rd<0>(fa, vb);
  pv_rd<1>(fb, vb); asm volatile("s_waitcnt lgkmcnt(8)" ::: "memory"); SBAR(); pv_mm(o[0], fa, pa0, pa1, pa2, pa3); SBAR();
  pv_rd<2>(fa, vb); asm volatile("s_waitcnt lgkmcnt(8)" ::: "memory"); SBAR(); pv_mm(o[1], fb, pa0, pa1, pa2, pa3); SBAR();
  pv_rd<3>(fb, vb); asm volatile("s_waitcnt lgkmcnt(8)" ::: "memory"); SBAR(); pv_mm(o[2], fa, pa0, pa1, pa2, pa3); SBAR();
  asm volatile("s_waitcnt lgkmcnt(0)" ::: "memory"); SBAR(); pv_mm(o[3], fb, pa0, pa1, pa2, pa3);
}

template <typename TQ, int MODE, bool NOMAX>
__device__ __forceinline__ void attn_dense_body(const TQ* __restrict__ Qb, const bf16* __restrict__ Kh, const bf16* __restrict__ Vh,
                                                const bf16* __restrict__ Gb, bf16* __restrict__ Ob, int ldo, float* __restrict__ lse_out, int seq, char* lds,
                                                const float* __restrict__ qnw, const float* __restrict__ rope, int tok0) {
  using St = Stage<bf16>; using SQ = Stage<TQ>;
  int tid_ = threadIdx.x; asm volatile("" : "+v"(tid_));
  const int tid = tid_, wid = tid >> 6, lane = tid & 63, r32 = lane & 31, hi = lane >> 5;
  bf16* V_lds = (bf16*)lds; bf16* K_lds = (bf16*)(lds + 3 * SHM_V);
  float* ws = (float*)(lds + 3 * SHM_V + 3 * SHM_K) + wid * 64; float* li_l = ws; float* al_l = ws + 32;
  float m_reg = -1e30f, l_reg = 0; f32x16 o[4] = {}; bf16x8 qr[8];
  const TQ* Qw = Qb + (long)(wid * QBLK + r32) * LDQ + hi * 8;
#pragma unroll
  for (int d0 = 0; d0 < 8; ++d0) qr[d0] = SQ::tobf(SQ::ld8(Qw + d0 * 16));
  {
    float qf[8][8]; float ss = 0.f;
#pragma unroll
    for (int d0 = 0; d0 < 8; ++d0) { const u32x4 w = *reinterpret_cast<const u32x4*>(&qr[d0]);
#pragma unroll
      for (int e = 0; e < 4; ++e) { qf[d0][2 * e] = __uint_as_float(w[e] << 16); qf[d0][2 * e + 1] = __uint_as_float(w[e] & 0xffff0000u); ss += qf[d0][2 * e] * qf[d0][2 * e] + qf[d0][2 * e + 1] * qf[d0][2 * e + 1]; } }
    { auto rr = __builtin_amdgcn_permlane32_swap(__float_as_uint(ss), __float_as_uint(ss), false, false); ss = __uint_as_float(rr[0]) + __uint_as_float(rr[1]); }
    const float rs = rsqrtf(ss * (1.0f / 128.0f) + 1e-6f) * (NOMAX ? SCALE * 1.4426950408889634f : 1.f);
    const int tpos = tok0 + wid * QBLK + r32;
#pragma unroll
    for (int ax = 0; ax < 2; ++ax) { const int pos = ax ? (tpos & 63) : (tpos >> 6);
#pragma unroll
      for (int h2 = 0; h2 < 2; ++h2) { const int d1 = 4 * ax + h2, d2 = d1 + 2, i0 = h2 * 16 + hi * 8;
        const float* cp = rope + pos * 32 + i0; const float* wp1 = qnw + d1 * 16 + hi * 8; const float* wp2 = qnw + d2 * 16 + hi * 8;
        float o1[8], o2[8];
        typedef float f32x4v __attribute__((ext_vector_type(4)));
        const f32x4v c0 = *reinterpret_cast<const f32x4v*>(cp), c1 = *reinterpret_cast<const f32x4v*>(cp + 4), s0 = *reinterpret_cast<const f32x4v*>(cp + 4096), s1 = *reinterpret_cast<const f32x4v*>(cp + 4100);
        const f32x4v g10 = *reinterpret_cast<const f32x4v*>(wp1), g11 = *reinterpret_cast<const f32x4v*>(wp1 + 4), g20 = *reinterpret_cast<const f32x4v*>(wp2), g21 = *reinterpret_cast<const f32x4v*>(wp2 + 4);
#pragma unroll
        for (int e = 0; e < 8; ++e) { const float w1 = e < 4 ? g10[e & 3] : g11[e & 3], w2 = e < 4 ? g20[e & 3] : g21[e & 3], cs = e < 4 ? c0[e & 3] : c1[e & 3], sn = e < 4 ? s0[e & 3] : s1[e & 3];
          const float a1 = qf[d1][e] * rs * w1, a2 = qf[d2][e] * rs * w2; o1[e] = a1 * cs - a2 * sn; o2[e] = a2 * cs + a1 * sn; }
        u32x4 p1 = {cvtpk(o1[0], o1[1]), cvtpk(o1[2], o1[3]), cvtpk(o1[4], o1[5]), cvtpk(o1[6], o1[7])}, p2 = {cvtpk(o2[0], o2[1]), cvtpk(o2[2], o2[3]), cvtpk(o2[4], o2[5]), cvtpk(o2[6], o2[7])};
        qr[d1] = *reinterpret_cast<bf16x8*>(&p1); qr[d2] = *reinterpret_cast<bf16x8*>(&p2); } } }
  const int sr = tid >> 4, sc = (tid & 15) * 8, vst0 = v_st(sr, sc), vst1 = v_st(32 + sr, sc);
  const int vb0 = (int)(uintptr_t)V_lds + v_rd_base(lane);
  struct { typename St::T vs0, vs1, ks0, ks1; } sr_[1];
#define SLOAD(i, k0) do { sr_[i].vs0 = St::ld8(&Vh[(long)((k0) + sr) * LDK + sc]); sr_[i].vs1 = St::ld8(&Vh[(long)((k0) + 32 + sr) * LDK + sc]); \
    sr_[i].ks0 = St::ld8(&Kh[(long)((k0) + sr) * LDK + sc]); sr_[i].ks1 = St::ld8(&Kh[(long)((k0) + 32 + sr) * LDK + sc]); } while (0)
#define SWRITE(boff, i) do { *(bf16x8*)((char*)V_lds + (boff) + vst0) = St::tobf(sr_[i].vs0);          \
    *(bf16x8*)((char*)V_lds + (boff) + vst1) = St::tobf(sr_[i].vs1); int kc = sc * 2;               \
    *(bf16x8*)((char*)K_lds + (boff) + KSWZ(sr, kc)) = St::tobf(sr_[i].ks0);                       \
    *(bf16x8*)((char*)K_lds + (boff) + KSWZ(32 + sr, kc)) = St::tobf(sr_[i].ks1); } while (0)
#define RESC(a) do { if constexpr (!NOMAX) if (__any((a) < 1.f)) { if (hi == 0) al_l[r32] = (a); asm volatile("s_waitcnt lgkmcnt(0)" ::: "memory"); \
    for (int d = 0; d < 4; ++d) for (int r = 0; r < 16; ++r) o[d][r] *= al_l[crow(r, hi)]; } } while (0)
  f32x16 pA0, pA1, pB0, pB1; float mnA, mnB, alA, alB; bf16x8 pa0, pa1, pa2, pa3; const int NT = seq / KVBLK;
  SLOAD(0, 0); asm volatile("s_waitcnt vmcnt(0)" ::: "memory"); SWRITE(0, 0);
  SLOAD(0, KVBLK); asm volatile("s_waitcnt vmcnt(0)" ::: "memory"); SWRITE((int)SHM_V, 0);
  if (2 < NT) SLOAD(0, 2 * KVBLK);
  __syncthreads();
  qkt(pA0, pA1, K_lds, qr, r32, hi); partialSM<NOMAX>(pA0, pA1, m_reg, mnA, alA);
  int ocur = (int)SHM_V, oprev = 0, onext = 2 * (int)SHM_V;
#define STEP(PC0, PC1, ALC, MNC, PP0, PP1, ALP, T) do { \
    if ((T) + 1 < NT) { asm volatile("s_waitcnt vmcnt(0)" ::: "memory"); SWRITE(onext, 0); } \
    SBAR(); qkt(PC0, PC1, (bf16*)((char*)K_lds + ocur), qr, r32, hi); \
    finishSM(PP0, PP1, ALP, l_reg, pa0, pa1, pa2, pa3); SBAR(); \
    if ((T) + 2 < NT) SLOAD(0, ((T) + 2) * KVBLK); SBAR(); \
    pv_d0(o, vb0 + oprev, pa0, pa1, pa2, pa3); partialSM<NOMAX>(PC0, PC1, m_reg, MNC, ALC); \
    RESC(ALC); __syncthreads(); \
    { const int t_ = oprev; oprev = ocur; ocur = onext; onext = t_; } } while (0)
  for (int t = 1; t + 1 < NT; t += 2) {
    STEP(pB0, pB1, alB, mnB, pA0, pA1, alA, t);
    STEP(pA0, pA1, alA, mnA, pB0, pB1, alB, t + 1);
  }
  STEP(pB0, pB1, alB, mnB, pA0, pA1, alA, NT - 1);
  finishSM(pB0, pB1, alB, l_reg, pa0, pa1, pa2, pa3); SBAR();
  pv_d0(o, vb0 + oprev, pa0, pa1, pa2, pa3);
#undef STEP
  if (hi == 0) li_l[r32] = l_reg; asm volatile("s_waitcnt lgkmcnt(0)" ::: "memory");
  float rli[16];
#pragma unroll
  for (int r = 0; r < 16; ++r) rli[r] = __builtin_amdgcn_rcpf(li_l[crow(r, hi)]);
  bf16* Ow = Ob + (long)(wid * QBLK) * ldo; const bf16* Gw = Gb + (long)(wid * QBLK) * LDG;
  u32x4 gat[8];
  if (MODE == 0) {
#pragma unroll
    for (int it = 0; it < 8; ++it) { const int idx = it * 64 + lane; gat[it] = *reinterpret_cast<const u32x4*>(Gw + (long)(idx >> 4) * LDG + (idx & 15) * 8); } }
  __syncthreads();
  char* ost = lds + wid * 8704;
#pragma unroll
  for (int r = 0; r < 16; ++r) { const int orow = crow(r, hi);
#pragma unroll
    for (int d0 = 0; d0 < 4; ++d0) { const float v = o[d0][r] * rli[r]; *(bf16*)(ost + orow * 272 + (d0 * 32 + r32) * 2) = (bf16)(cvtpk(v, v) & 0xffffu); } }
  asm volatile("s_waitcnt lgkmcnt(0)" ::: "memory");
  if (MODE == 1) { if (hi == 0) lse_out[wid * QBLK + r32] = NOMAX ? __logf(l_reg) : m_reg * SCALE + __logf(l_reg); }
#pragma unroll
  for (int it = 0; it < 8; ++it) { const int idx = it * 64 + lane, row = idx >> 4, ck = idx & 15;
    u32x4 v = *reinterpret_cast<const u32x4*>(ost + row * 272 + ck * 16);
    if (MODE == 0) { const u32x4 g = gat[it];
#pragma unroll
      for (int e = 0; e < 4; ++e) { const float g0 = __uint_as_float(g[e] << 16), g1 = __uint_as_float(g[e] & 0xffff0000u), v0 = __uint_as_float(v[e] << 16), v1 = __uint_as_float(v[e] & 0xffff0000u);
        v[e] = cvtpk(v0 * g0 * __builtin_amdgcn_rcpf(1.f + __expf(-g0)), v1 * g1 * __builtin_amdgcn_rcpf(1.f + __expf(-g1))); } }
    *reinterpret_cast<u32x4*>(Ow + (long)row * ldo + ck * 8) = v; }
#undef SLOAD
#undef SWRITE
#undef RESC
}

}

#define LAS __attribute__((address_space(3)))
typedef unsigned short bf16_t;
typedef short bf16x8 __attribute__((ext_vector_type(8)));
typedef float f32x4 __attribute__((ext_vector_type(4)));
typedef float f32x2 __attribute__((ext_vector_type(2)));
typedef unsigned u32x4 __attribute__((ext_vector_type(4)));
typedef unsigned u32x2 __attribute__((ext_vector_type(2)));

constexpr int NB = 2, SEQL = 8192, M = NB * SEQL, DM = 1024, DIN = 4608, DMIX = 2048, DEPTH = 4;
constexpr int C_UPOOL = 0, C_GPOOL = 512, C_ULRU = 1024, C_GLRU = 1792, C_Q = 2560, C_K = 3328, C_V = 3584, C_GATT = 3840;
constexpr int Y_POOL = 0, Y_LRU = 512, Y_ATT = 1280;
constexpr int NCHUNK = 64;
constexpr size_t WS_Z = 0, WS_Y = WS_Z + (size_t)M * DIN * 2, WS_PF = WS_Y + (size_t)M * DMIX * 2, WS_PB = WS_PF + (size_t)M * 768 * 2,
                 WS_XB = WS_PF  , WS_WIN = WS_PB + (size_t)M * 768 * 2, WS_WOUT = WS_WIN + (size_t)DIN * DM * 2,
                 WS_POOLW = WS_WOUT + (size_t)DM * DMIX * 2, WS_LRUW = WS_POOLW + (size_t)DEPTH * 4 * 16384 * 2, WS_SSQ = WS_LRUW + (size_t)DEPTH * 24 * 16384 * 2,
                 WS_SUMM = WS_SSQ + (size_t)M * 16 * 4, WS_ROPE = WS_SUMM + (size_t)NB * NCHUNK * 2 * 2 * 768 * 4, WS_BAR = WS_ROPE + 2 * 128 * 32 * 4, WS_PART = WS_BAR + 16384  , WS_LSE = WS_PART + (size_t)128 * 256 * 128 * 2  , WS_END = WS_LSE + (size_t)128 * 2 * 256 * 4;
static_assert((size_t)M * DM * 2 <= 2 * (size_t)M * 768 * 2, "XB overlay fits");
static_assert(WS_END <= 301989888ull, "workspace budget (4 x largest input)");
constexpr int LDS_BYTES = 143360;

struct Args { const float* in[15]; float* out; unsigned char* ws; float inv[32]; };

__device__ __forceinline__ float bf2f(unsigned v) { return __uint_as_float(v << 16); }
__device__ __forceinline__ float bflo(unsigned w) { return __uint_as_float(w << 16); }
__device__ __forceinline__ float bfhi(unsigned w) { return __uint_as_float(w & 0xffff0000u); }
__device__ __forceinline__ unsigned pk2(float lo, float hi) { unsigned r; asm volatile("v_cvt_pk_bf16_f32 %0, %1, %2" : "=v"(r) : "v"(lo), "v"(hi)); return r; }
__device__ __forceinline__ float silu_f(float g) { return g * __builtin_amdgcn_rcpf(1.f + __expf(-g)); }
__device__ __forceinline__ float sigmoid_f(float g) { return __builtin_amdgcn_rcpf(1.f + __expf(-g)); }
__device__ __forceinline__ float wave_sum(float v) {
#pragma unroll
    for (int o = 1; o < 64; o <<= 1) v += __shfl_xor(v, o);
    return v;
}
#define LDS_WAIT() asm volatile("s_waitcnt lgkmcnt(0)" ::: "memory")

__device__ __forceinline__ void transpose_item(const float* W, int N, bf16_t* WT, int K, const float* kscale, LAS float* scr, int kb, int nb, int lane) {
    const int k0 = 64 * kb, n0 = 32 * nb;
#pragma unroll
    for (int i = 0; i < 32; ++i) { const int kk = 2 * i + (lane >> 5); float v = W[(size_t)(k0 + kk) * N + n0 + (lane & 31)]; if (kscale) v *= kscale[k0 + kk]; scr[kk * 33 + (lane & 31)] = v; }
    LDS_WAIT();
    const int c = lane & 7;
#pragma unroll
    for (int j = 0; j < 4; ++j) { const int n = (lane >> 3) + 8 * j; const LAS float* s = scr + (8 * c) * 33 + n;
        u32x4 o; o.x = pk2(s[0 * 33], s[1 * 33]); o.y = pk2(s[2 * 33], s[3 * 33]); o.z = pk2(s[4 * 33], s[5 * 33]); o.w = pk2(s[6 * 33], s[7 * 33]);
        *(u32x4*)(WT + (size_t)(n0 + n) * K + k0 + 8 * c) = o; }
    LDS_WAIT();
}
__device__ __forceinline__ void transpose_win(const Args& a, int l, LAS float* scr, int gw, int NGW, int lane) {
    const float* W = a.in[2] + (size_t)l * DM * DIN; bf16_t* WT = (bf16_t*)(a.ws + WS_WIN); const float* g = a.in[1] + l * DM;
    for (int it = gw; it < (DM / 64) * (DIN / 32); it += NGW) transpose_item(W, DIN, WT, DM, g, scr, it / (DIN / 32), it % (DIN / 32), lane);
}
__device__ __forceinline__ void transpose_wout(const Args& a, int l, LAS float* scr, int gw, int NGW, int lane) {
    const float* W = a.in[14] + (size_t)l * DMIX * DM; bf16_t* WT = (bf16_t*)(a.ws + WS_WOUT);
    for (int it = gw; it < (DMIX / 64) * (DM / 32); it += NGW) transpose_item(W, DM, WT, DMIX, nullptr, scr, it / (DM / 32), it % (DM / 32), lane);
}

__device__ __forceinline__ void sincos_d(double x, float& c, float& s) {
    const double TWO_PI = 6.283185307179586476925287;
    const double r = x - TWO_PI * rint(x / TWO_PI), r2 = r * r;
    double sv = 0.0, cv = 0.0;
#pragma unroll
    for (int k = 14; k >= 0; --k) { sv = sv * r2 / ((2.0 * k + 2.0) * (2.0 * k + 3.0)); sv = 1.0 - sv; cv = cv * r2 / ((2.0 * k + 1.0) * (2.0 * k + 2.0)); cv = 1.0 - cv; }
    s = (float)(sv * r); c = (float)cv;
}
__device__ __forceinline__ void p0_prologue(const Args& a, LAS unsigned char* lds) {
    int tid_ = threadIdx.x; asm volatile("" : "+v"(tid_));
    const int tid = tid_, lane = tid & 63, wid = tid >> 6, G = gridDim.x, gw = blockIdx.x * 8 + wid, NGW = G * 8;
    LAS float* scr = (LAS float*)(lds + wid * 8448);
    transpose_win(a, 0, scr, gw, NGW, lane);
    for (int it = gw; it < (16 + 96) * 8; it += NGW) { const int mat = it >> 3, sub = it & 7; const float* W; bf16_t* WT;
        if (mat < 16) { W = a.in[3] + (size_t)mat * 16384; WT = (bf16_t*)(a.ws + WS_POOLW) + (size_t)mat * 16384; }
        else { const int q = mat - 16, gate = q / 48, r = q % 48, l = r / 12, dir = (r % 12) / 6, blk = r % 6;
            W = a.in[gate ? 9 : 7] + (size_t)r * 16384; WT = (bf16_t*)(a.ws + WS_LRUW) + ((((size_t)l * 6 + blk) * 2 + dir) * 2 + gate) * 16384; }
        transpose_item(W, 128, WT, 128, nullptr, scr, sub >> 2, sub & 3, lane); }
    bf16_t* XB = (bf16_t*)(a.ws + WS_XB); float* ssq = (float*)(a.ws + WS_SSQ);
    for (int m0 = 2 * gw; m0 < M; m0 += 2 * NGW) { f32x4 v[2][4]; float s[2] = {0.f, 0.f};
#pragma unroll
        for (int q = 0; q < 2; ++q) { const f32x4* xr = (const f32x4*)(a.in[0] + (size_t)(m0 + q) * DM) + lane;
#pragma unroll
            for (int j = 0; j < 4; ++j) v[q][j] = xr[64 * j]; }
#pragma unroll
        for (int q = 0; q < 2; ++q) { const int m = m0 + q;
#pragma unroll
            for (int j = 0; j < 4; ++j) s[q] += (v[q][j][0] * v[q][j][0] + v[q][j][1] * v[q][j][1]) + (v[q][j][2] * v[q][j][2] + v[q][j][3] * v[q][j][3]);
            s[q] = wave_sum(s[q]);
            u32x2* o8 = (u32x2*)(XB + (size_t)m * DM) + lane;
#pragma unroll
            for (int j = 0; j < 4; ++j) { u32x2 w; w.x = pk2(v[q][j][0], v[q][j][1]); w.y = pk2(v[q][j][2], v[q][j][3]); o8[64 * j] = w; }
            if (lane < 16) ssq[(size_t)m * 16 + lane] = lane == 0 ? s[q] : 0.f; } }
    float* rope = (float*)(a.ws + WS_ROPE);
    for (int e = blockIdx.x * 512 + tid; e < 128 * 32; e += G * 512) { const float ang = (float)(e >> 5) * a.inv[e & 31]; float c, s; sincos_d((double)ang, c, s); rope[e] = c; rope[4096 + e] = s; }
}

template <int DIR>
__device__ __forceinline__ void lru_scan(f32x4 (&accR)[8], f32x4 (&accI)[8], const LAS bf16_t* At, float vbr, float vbi, float clam, int d, int fr, int fq, int lane, float& Pc_out, float& hc_out) {
    const int qo = DIR ? 3 - fq : fq, src1 = (DIR ? lane + 16 : lane - 16) & 63, src2 = (DIR ? lane + 32 : lane - 32) & 63, lastl = DIR ? fr : 48 + fr;
    float Pc = 1.f, hc = 0.f;
#pragma unroll
    for (int ms = 0; ms < 8; ++ms) { const int m = DIR ? 7 - ms : ms;
        float Pl[4], hl[4]; float P = 1.f, h = 0.f;
#pragma unroll
        for (int s = 0; s < 4; ++s) { const int j = DIR ? 3 - s : s; const int tok = m * 16 + 4 * fq + j;
            const float r = __builtin_amdgcn_rcpf(1.f + __builtin_amdgcn_exp2f(fmaf(accR[m][j], -1.4426950408889634f, vbr)));
            const float ig = __builtin_amdgcn_rcpf(1.f + __builtin_amdgcn_exp2f(fmaf(accI[m][j], -1.4426950408889634f, vbi)));
            const float aa = __builtin_amdgcn_exp2f(clam * r);
            const float om = fmaxf(fmaf(-aa, aa, 1.f), 0.f);
            const float x = bf2f(At[tok * 136 + d]);
            const float inp = __builtin_amdgcn_sqrtf(om) * (ig * x);
            h = aa * h + inp; P = P * aa; Pl[s] = P; hl[s] = h; }
        float Pt = P, ht = h, Pp, hp;
        Pp = __shfl(Pt, src1); hp = __shfl(ht, src1); if (qo >= 1) { ht = ht + Pt * hp; Pt = Pt * Pp; }
        Pp = __shfl(Pt, src2); hp = __shfl(ht, src2); if (qo >= 2) { ht = ht + Pt * hp; Pt = Pt * Pp; }
        float Pe = __shfl(Pt, src1), he = __shfl(ht, src1); if (qo == 0) { Pe = 1.f; he = 0.f; }
        const float h_in = he + Pe * hc, P_in = Pe * Pc;
#pragma unroll
        for (int s = 0; s < 4; ++s) { const int j = DIR ? 3 - s : s; accR[m][j] = hl[s] + Pl[s] * h_in; accI[m][j] = Pl[s] * P_in; }
        hc = __shfl(accR[m][DIR ? 0 : 3], lastl); Pc = __shfl(accI[m][DIR ? 0 : 3], lastl); }
    Pc_out = Pc; hc_out = hc;
}
__device__ __forceinline__ void lru_tile(const Args& a, int l, int b, int c, int k, LAS unsigned char* lds, unsigned* xb_readers = nullptr, unsigned need = 0u) {
    int tid_ = threadIdx.x; asm volatile("" : "+v"(tid_));
    const int tid = tid_, lane = tid & 63, wid = __builtin_amdgcn_readfirstlane(tid >> 6), fr = lane & 15, fq = lane >> 4;
    LAS bf16_t* At = (LAS bf16_t*)lds;
    LAS bf16_t* Ost = (LAS bf16_t*)(lds + 34816);
    const bf16_t* Z = (const bf16_t*)(a.ws + WS_Z); bf16_t* Y = (bf16_t*)(a.ws + WS_Y);
    const int t0 = c * 128; const size_t r0 = (size_t)b * SEQL + t0;
    const int d = wid * 16 + fr;
    bf16x8 wR[2][4], wI[2][4];
#pragma unroll
    for (int dir = 0; dir < 2; ++dir) { const bf16_t* WT = (const bf16_t*)(a.ws + WS_LRUW) + ((((size_t)l * 6 + k) * 2 + dir) * 2) * 16384;
#pragma unroll
        for (int kk = 0; kk < 4; ++kk) { const size_t o = (size_t)d * 128 + kk * 32 + fq * 8; wR[dir][kk] = *(const bf16x8*)(WT + o); wI[dir][kk] = *(const bf16x8*)(WT + 16384 + o); } }
    {
        const int cgi = tid & 15, tg = tid >> 4, ch = k * 128 + cgi * 8;
        const float* cw = a.in[5] + (size_t)l * 4 * 768 + ch; const float* cb = a.in[6] + (size_t)l * 768 + ch;
        float w[4][8], bb[8];
#pragma unroll
        for (int kk = 0; kk < 4; ++kk) { const f32x4 w0 = *(const f32x4*)(cw + kk * 768), w1 = *(const f32x4*)(cw + kk * 768 + 4);
#pragma unroll
            for (int e = 0; e < 4; ++e) { w[kk][e] = w0[e]; w[kk][4 + e] = w1[e]; } }
        { const f32x4 b0 = *(const f32x4*)cb, b1 = *(const f32x4*)(cb + 4);
#pragma unroll
          for (int e = 0; e < 4; ++e) { bb[e] = b0[e]; bb[4 + e] = b1[e]; } }
        float u[7][8];
#pragma unroll
        for (int i = 0; i < 7; ++i) { const int t = t0 + tg * 4 - 1 + i; u32x4 raw = {0u, 0u, 0u, 0u};
            if (t >= 0 && t < SEQL) raw = *(const u32x4*)(Z + ((size_t)b * SEQL + t) * DIN + C_ULRU + ch);
#pragma unroll
            for (int e = 0; e < 4; ++e) { u[i][2 * e] = bflo(raw[e]); u[i][2 * e + 1] = bfhi(raw[e]); } }
#pragma unroll
        for (int i = 0; i < 4; ++i) { float xc[8];
#pragma unroll
            for (int e = 0; e < 8; ++e) xc[e] = bb[e] + u[i][e] * w[0][e] + u[i + 1][e] * w[1][e] + u[i + 2][e] * w[2][e] + u[i + 3][e] * w[3][e];
            u32x4 o; o.x = pk2(xc[0], xc[1]); o.y = pk2(xc[2], xc[3]); o.z = pk2(xc[4], xc[5]); o.w = pk2(xc[6], xc[7]);
            *(LAS u32x4*)(At + (tg * 4 + i) * 136 + cgi * 8) = o; }
    }
    __syncthreads();
    f32x4 hf[8];
#pragma unroll
    for (int dir = 0; dir < 2; ++dir) {
        const float* br = a.in[8] + ((size_t)l * 2 + dir) * 768 + k * 128; const float* bi = a.in[10] + ((size_t)l * 2 + dir) * 768 + k * 128; const float* lam = a.in[11] + ((size_t)l * 2 + dir) * 768 + k * 128;
        float* summ = (float*)(a.ws + WS_SUMM) + ((((size_t)b * NCHUNK + c) * 2 + dir) * 2) * 768 + k * 128;
        f32x4 accR[8], accI[8];
#pragma unroll
        for (int m = 0; m < 8; ++m) { accR[m] = (f32x4){0.f, 0.f, 0.f, 0.f}; accI[m] = (f32x4){0.f, 0.f, 0.f, 0.f}; }
        {
#pragma unroll
          for (int m = 0; m < 8; ++m) { bf16x8 af[4];
#pragma unroll
              for (int kk = 0; kk < 4; ++kk) af[kk] = *(const LAS bf16x8*)(At + (m * 16 + fr) * 136 + kk * 32 + fq * 8);
#pragma unroll
              for (int kk = 0; kk < 4; ++kk) { accR[m] = __builtin_amdgcn_mfma_f32_16x16x32_bf16(af[kk], wR[dir][kk], accR[m], 0, 0, 0);
                                               accI[m] = __builtin_amdgcn_mfma_f32_16x16x32_bf16(af[kk], wI[dir][kk], accI[m], 0, 0, 0); } } }
        const float lm = lam[d], clam = 8.0f * 1.4426950408889634f * (fminf(lm, 0.f) - log1pf(__expf(-fabsf(lm))));
        const float nbr = -1.4426950408889634f * br[d], nbi = -1.4426950408889634f * bi[d];
        float Pc, hc;
        if (dir == 0) lru_scan<0>(accR, accI, At, nbr, nbi, clam, d, fr, fq, lane, Pc, hc);
        else          lru_scan<1>(accR, accI, At, nbr, nbi, clam, d, fr, fq, lane, Pc, hc);
        if (fq == 0) { summ[d] = Pc; summ[768 + d] = hc; }
        LAS bf16_t* Pst = Ost + (1 + dir) * (128 * 136);
#pragma unroll
        for (int m = 0; m < 8; ++m)
#pragma unroll
            for (int j = 0; j < 4; ++j) { const int tok = m * 16 + 4 * fq + j;
                Pst[tok * 136 + d] = (bf16_t)(pk2(accI[m][j], 0.f) & 0xffffu);
                if (dir == 0) hf[m][j] = accR[m][j]; else Ost[tok * 136 + d] = (bf16_t)(pk2(hf[m][j] + accR[m][j], 0.f) & 0xffffu); }
    }
    if (need) { if (tid == 0) { unsigned sp = 0; while (__hip_atomic_load(xb_readers, __ATOMIC_RELAXED, __HIP_MEMORY_SCOPE_AGENT) < need) { __builtin_amdgcn_s_sleep(2); if (++sp > (1u << 22)) break; } } }
    __syncthreads();
    {
        bf16_t* PF = (bf16_t*)(a.ws + WS_PF); bf16_t* PB = (bf16_t*)(a.ws + WS_PB);
#pragma unroll
        for (int i = 0; i < 12; ++i) { const int idx = tid + i * 512, arr = idx >> 11, row = (idx >> 4) & 127, ck = idx & 15;
            const u32x4 v = *(const LAS u32x4*)(Ost + arr * (128 * 136) + row * 136 + ck * 8);
            bf16_t* dst = arr == 0 ? Y + (r0 + row) * DMIX + Y_LRU + k * 128 + ck * 8 : (arr == 1 ? PF : PB) + (r0 + row) * 768 + k * 128 + ck * 8;
            *(u32x4*)dst = v; }
    }
}
__device__ __forceinline__ void pool_tile(const Args& a, int l, int b, int c, int g, LAS unsigned char* lds) {
    int tid_ = threadIdx.x; asm volatile("" : "+v"(tid_));
    const int tid = tid_, lane = tid & 63, wid = tid >> 6, fr = lane & 15, fq = lane >> 4;
    LAS bf16_t* U = (LAS bf16_t*)lds;
    LAS bf16_t* At = (LAS bf16_t*)(lds + 39168);
    LAS bf16_t* Wl = (LAS bf16_t*)(lds + 73984);
    const bf16_t* Z = (const bf16_t*)(a.ws + WS_Z); bf16_t* Y = (bf16_t*)(a.ws + WS_Y);
    const int t0 = c * 128; const size_t r0 = (size_t)b * SEQL + t0; const size_t row = r0 + wid * 16 + fr;
    const bf16_t* WT = (const bf16_t*)(a.ws + WS_POOLW) + ((size_t)l * 4 + g) * 16384;
    u32x4 ur[5], wr_[4]; u32x2 gp[8]; f32x4 sc[8];
#pragma unroll
    for (int i = 0; i < 5; ++i) { const int idx = tid + i * 512, rw = idx >> 4, ck = idx & 15, t = t0 - 8 + rw; ur[i] = (u32x4){0u, 0u, 0u, 0u};
        if (idx < 144 * 16 && t >= 0 && t < SEQL) ur[i] = *(const u32x4*)(Z + ((size_t)b * SEQL + t) * DIN + C_UPOOL + g * 128 + ck * 8); }
#pragma unroll
    for (int i = 0; i < 4; ++i) { const int idx = tid + i * 512; wr_[i] = *(const u32x4*)(WT + (size_t)idx * 8); }
#pragma unroll
    for (int n = 0; n < 8; ++n) { const int d0 = n * 16 + 4 * fq; gp[n] = *(const u32x2*)(Z + row * DIN + C_GPOOL + g * 128 + d0); sc[n] = *(const f32x4*)(a.in[4] + (size_t)l * 512 + g * 128 + d0); }
#pragma unroll
    for (int i = 0; i < 5; ++i) { const int idx = tid + i * 512, rw = idx >> 4, ck = idx & 15; if (idx < 144 * 16) *(LAS u32x4*)(U + rw * 136 + ck * 8) = ur[i]; }
#pragma unroll
    for (int i = 0; i < 4; ++i) { const int idx = tid + i * 512, rw = idx >> 4, ck = idx & 15; *(LAS u32x4*)(Wl + rw * 136 + ck * 8) = wr_[i]; }
    __syncthreads();
    { const int cgi = tid & 15, tg = tid >> 4, half = 1 << g;
#pragma unroll
      for (int i = 0; i < 4; ++i) { const int tl = tg * 4 + i, t = t0 + tl; const int lo = max(t - half, 0), hi = min(t + half, SEQL);
          float s[8];
#pragma unroll
          for (int e = 0; e < 8; ++e) s[e] = 0.f;
          for (int rr = lo; rr < hi; ++rr) { const u32x4 raw = *(const LAS u32x4*)(U + (rr - t0 + 8) * 136 + cgi * 8);
#pragma unroll
              for (int e = 0; e < 4; ++e) { s[2 * e] += bflo(raw[e]); s[2 * e + 1] += bfhi(raw[e]); } }
          const float inv = 1.0f / (float)(hi - lo);
          const u32x4 self = *(const LAS u32x4*)(U + (tl + 8) * 136 + cgi * 8);
          u32x4 o;
#pragma unroll
          for (int e = 0; e < 4; ++e) o[e] = pk2(s[2 * e] * inv - bflo(self[e]), s[2 * e + 1] * inv - bfhi(self[e]));
          *(LAS u32x4*)(At + tl * 136 + cgi * 8) = o; } }
    __syncthreads();
    f32x4 acc[8];
#pragma unroll
    for (int n = 0; n < 8; ++n) acc[n] = (f32x4){0.f, 0.f, 0.f, 0.f};
#pragma unroll
    for (int kk = 0; kk < 4; ++kk) { const bf16x8 af = *(const LAS bf16x8*)(At + (wid * 16 + fr) * 136 + kk * 32 + fq * 8);
#pragma unroll
        for (int n = 0; n < 8; ++n) { const bf16x8 wf = *(const LAS bf16x8*)(Wl + (n * 16 + fr) * 136 + kk * 32 + fq * 8);
            acc[n] = __builtin_amdgcn_mfma_f32_16x16x32_bf16(wf, af, acc[n], 0, 0, 0); } }
#pragma unroll
    for (int n = 0; n < 8; ++n) { const int d0 = n * 16 + 4 * fq;
        u32x2 o; o.x = pk2(acc[n][0] * sc[n][0] * silu_f(bflo(gp[n].x)), acc[n][1] * sc[n][1] * silu_f(bfhi(gp[n].x)));
                 o.y = pk2(acc[n][2] * sc[n][2] * silu_f(bflo(gp[n].y)), acc[n][3] * sc[n][3] * silu_f(bfhi(gp[n].y)));
        *(u32x2*)(Y + row * DMIX + Y_POOL + g * 128 + d0) = o; }
}
__device__ __forceinline__ void rope_unit(const Args& a, int l, int unit, bool wr = true) {
    int tid_ = threadIdx.x; asm volatile("" : "+v"(tid_));
    const int tid = tid_, s16 = tid & 15, ax = s16 >> 3, i0 = (s16 & 7) * 4, kh = (tid >> 4) & 1;
    bf16_t* Z = (bf16_t*)(a.ws + WS_Z); const float* rope = (const float*)(a.ws + WS_ROPE);
    const float* nw = a.in[13] + l * 128 + 64 * ax + i0;
    const f32x4 w1 = *(const f32x4*)nw, w2 = *(const f32x4*)(nw + 32);
    u32x2 r1[8], r2[8]; f32x4 cs[8], sn[8];
#pragma unroll
    for (int it = 0; it < 8; ++it) { const int ri = it * 32 + (tid >> 4), tok = unit * 128 + (ri >> 1);
        const bf16_t* p = Z + (size_t)tok * DIN + C_K + kh * 128 + 64 * ax + i0;
        r1[it] = *(const u32x2*)p; r2[it] = *(const u32x2*)(p + 32);
        const int tpos = tok & (SEQL - 1), pos = ax ? (tpos & 63) : (tpos >> 6);
        cs[it] = *(const f32x4*)(rope + pos * 32 + i0); sn[it] = *(const f32x4*)(rope + 4096 + pos * 32 + i0); }
#pragma unroll
    for (int it = 0; it < 8; ++it) { const int ri = it * 32 + (tid >> 4), tok = unit * 128 + (ri >> 1);
        bf16_t* p = Z + (size_t)tok * DIN + C_K + kh * 128 + 64 * ax + i0;
        float x1[4] = {bflo(r1[it].x), bfhi(r1[it].x), bflo(r1[it].y), bfhi(r1[it].y)}, x2[4] = {bflo(r2[it].x), bfhi(r2[it].x), bflo(r2[it].y), bfhi(r2[it].y)};
        float ss = 0.f;
#pragma unroll
        for (int e = 0; e < 4; ++e) ss += x1[e] * x1[e] + x2[e] * x2[e];
        ss += __shfl_xor(ss, 1); ss += __shfl_xor(ss, 2); ss += __shfl_xor(ss, 4); ss += __shfl_xor(ss, 8);
        const float rs = rsqrtf(ss * (1.0f / 128.0f) + 1e-6f);
        float o1[4], o2[4];
#pragma unroll
        for (int e = 0; e < 4; ++e) { const float a1 = x1[e] * rs * w1[e], a2 = x2[e] * rs * w2[e]; o1[e] = a1 * cs[it][e] - a2 * sn[it][e]; o2[e] = a2 * cs[it][e] + a1 * sn[it][e]; }
        u32x2 q1, q2; q1.x = pk2(o1[0], o1[1]); q1.y = pk2(o1[2], o1[3]); q2.x = pk2(o2[0], o2[1]); q2.y = pk2(o2[2], o2[3]);
        if (wr) { *(u32x2*)p = q1; *(u32x2*)(p + 32) = q2; } }
}
__device__ __forceinline__ void fixup_unit(const Args& a, int f, LAS unsigned char* lds, bool wr = true) {
    int tid_ = threadIdx.x; asm volatile("" : "+v"(tid_));
    const int tid = tid_, b = f >> 7, c = (f >> 1) & 63, hc = f & 1, ch0 = hc * 384;
    LAS float* car = (LAS float*)lds;
    const float* summ = (const float*)(a.ws + WS_SUMM) + (size_t)b * NCHUNK * 4 * 768 + ch0;
    __syncthreads();
    {
        float H[2] = {0.f, 0.f}; int dr[2], ch[2]; bool live[2];
#pragma unroll
        for (int i = 0; i < 2; ++i) { const int q = tid + 512 * i; live[i] = q < 768; dr[i] = q >= 384; ch[i] = q - 384 * dr[i]; }
        const int nsteps = max(c, NCHUNK - 1 - c);
        for (int s0 = 0; s0 < nsteps; s0 += 16) { float P[2][16], h[2][16];
#pragma unroll
            for (int e = 0; e < 16; ++e)
#pragma unroll
                for (int i = 0; i < 2; ++i) { const int st = s0 + e, j = dr[i] ? NCHUNK - 1 - st : st; const bool ok = live[i] && (dr[i] ? (j > c) : (j < c));
                    P[i][e] = 1.f; h[i][e] = 0.f;
                    if (ok) { const float* sp = summ + ((size_t)j * 4 + 2 * dr[i]) * 768 + ch[i]; P[i][e] = sp[0]; h[i][e] = sp[768]; } }
#pragma unroll
            for (int e = 0; e < 16; ++e)
#pragma unroll
                for (int i = 0; i < 2; ++i) H[i] = h[i][e] + P[i][e] * H[i]; }
#pragma unroll
        for (int i = 0; i < 2; ++i) if (live[i]) car[tid + 512 * i] = H[i];
    }
    __syncthreads();
    const bf16_t* Z = (const bf16_t*)(a.ws + WS_Z); bf16_t* Y = (bf16_t*)(a.ws + WS_Y); const bf16_t* PF = (const bf16_t*)(a.ws + WS_PF); const bf16_t* PB = (const bf16_t*)(a.ws + WS_PB);
    const size_t r0 = (size_t)b * SEQL + c * 128;
#pragma unroll
    for (int bt = 0; bt < 2; ++bt) {
        u32x4 hs[6], pf[6], pb[6], gg[6];
#pragma unroll
        for (int i = 0; i < 6; ++i) { const int idx = tid + (bt * 6 + i) * 512, row = idx / 48, ck = idx - row * 48, cc = ch0 + ck * 8; const size_t rr = r0 + row;
            hs[i] = *(const u32x4*)(Y + rr * DMIX + Y_LRU + cc); pf[i] = *(const u32x4*)(PF + rr * 768 + cc); pb[i] = *(const u32x4*)(PB + rr * 768 + cc); gg[i] = *(const u32x4*)(Z + rr * DIN + C_GLRU + cc); }
#pragma unroll
        for (int i = 0; i < 6; ++i) { const int idx = tid + (bt * 6 + i) * 512, row = idx / 48, ck = idx - row * 48, cc = ch0 + ck * 8; const size_t rr = r0 + row;
            const f32x4 f0 = *(const LAS f32x4*)(car + ck * 8), f1 = *(const LAS f32x4*)(car + ck * 8 + 4), b0 = *(const LAS f32x4*)(car + 384 + ck * 8), b1 = *(const LAS f32x4*)(car + 384 + ck * 8 + 4);
            const float cf[8] = {f0[0], f0[1], f0[2], f0[3], f1[0], f1[1], f1[2], f1[3]}, cb[8] = {b0[0], b0[1], b0[2], b0[3], b1[0], b1[1], b1[2], b1[3]};
            u32x4 o;
#pragma unroll
            for (int e = 0; e < 4; ++e) o[e] = pk2((bflo(hs[i][e]) + bflo(pf[i][e]) * cf[2 * e] + bflo(pb[i][e]) * cb[2 * e]) * silu_f(bflo(gg[i][e])),
                                                   (bfhi(hs[i][e]) + bfhi(pf[i][e]) * cf[2 * e + 1] + bfhi(pb[i][e]) * cb[2 * e + 1]) * silu_f(bfhi(gg[i][e])));
            if (wr) *(u32x4*)(Y + rr * DMIX + Y_LRU + cc) = o; } }
}

#define XB_TMO      128
#define XB_XCNT(j)  (256  + 64 * (j))
#define XB_XSUB(j)  (1280 + 64 * (j))
#define XB_XGEN(j)  (2304 + 64 * (j))
#define XB_TOP      3328
#define XB_TOPGEN   3392
#define XCD_BAR_WORDS 3456
#define XB_SPIN_CAP (1u << 18)

__device__ __forceinline__ unsigned xb_ld(unsigned* p)              { return __hip_atomic_load(p, __ATOMIC_RELAXED, __HIP_MEMORY_SCOPE_AGENT); }
__device__ __forceinline__ unsigned xb_add(unsigned* p, unsigned v) { return __hip_atomic_fetch_add(p, v, __ATOMIC_RELAXED, __HIP_MEMORY_SCOPE_AGENT); }
__device__ __forceinline__ unsigned xb_xcc_id() { return (unsigned)__builtin_amdgcn_s_getreg((3 << 11) | 20) & 0xFu; }
#define XB_SPIN(cond, bar) do { unsigned _sp = 0; while (cond) { __builtin_amdgcn_s_sleep(1); \
    if ((++_sp & 255u) == 0u) { if (xb_ld(&(bar)[XB_TMO])) break; if (_sp > XB_SPIN_CAP) { atomicAdd(&(bar)[XB_TMO], 1u); break; } } } } while (0)

struct XcdBarrier {
    unsigned* bar; unsigned x;
    volatile LAS unsigned* st;
};

__device__ __forceinline__ XcdBarrier xcd_barrier_post(unsigned* bar, volatile LAS unsigned* st) {
    XcdBarrier b; b.bar = bar; b.x = xb_xcc_id(); b.st = st;
    if (threadIdx.x == 0) (void)xb_add(&bar[XB_XCNT(b.x)], 1u);
    return b;
}
__device__ __forceinline__ void xcd_barrier_complete(unsigned* bar, unsigned x, unsigned& nloc, unsigned& nx) {
    const unsigned G = gridDim.x * gridDim.y * gridDim.z;
    unsigned sum, cnt, mine, sp = 0u;
    for (;;) {
        sum = 0u; cnt = 0u; mine = 0u;
#pragma unroll
        for (unsigned j = 0; j < 16; ++j) { const unsigned c = xb_ld(&bar[XB_XCNT(j)]); sum += c; cnt += (c > 0u) ? 1u : 0u; mine = (j == x) ? c : mine; }
        if (sum == G) break;
        __builtin_amdgcn_s_sleep(1);
        if ((++sp & 255u) == 0u) { if (xb_ld(&bar[XB_TMO])) break; if (sp > XB_SPIN_CAP) { atomicAdd(&bar[XB_TMO], 1u); break; } }
    }
    nloc = mine > 0u ? mine : 1u; nx = cnt > 0u ? cnt : 1u;
}

__device__ __forceinline__ void xcd_barrier(const XcdBarrier& b) {
    asm volatile("s_waitcnt vmcnt(0)" ::: "memory");
    __syncthreads();
    if (threadIdx.x == 0) {
        unsigned* bar = b.bar; const unsigned bx = xb_xcc_id();
        __builtin_amdgcn_s_waitcnt(0);
        unsigned nloc = b.st[0], nx = b.st[1];
        if (nloc == 0u) { xcd_barrier_complete(bar, bx, nloc, nx); b.st[0] = nloc; b.st[1] = nx; }
        const unsigned old = xb_add(&bar[XB_XSUB(bx)], 1u);
        const unsigned gen = old / nloc;
        if (old + 1u == (gen + 1u) * nloc) {
            __builtin_amdgcn_fence(__ATOMIC_RELEASE, "agent");
            asm volatile("s_waitcnt vmcnt(0)" ::: "memory");
            const unsigned og = xb_add(&bar[XB_TOP], 1u);
            const unsigned tg = og / nx;
            if (og + 1u == (tg + 1u) * nx) xb_add(&bar[XB_TOPGEN], 1u);
            else XB_SPIN(xb_ld(&bar[XB_TOPGEN]) == tg, bar);
            __builtin_amdgcn_fence(__ATOMIC_ACQUIRE, "agent");
            xb_add(&bar[XB_XGEN(bx)], 1u);
            asm volatile("s_waitcnt vmcnt(0)" ::: "memory");
        } else {
            XB_SPIN(xb_ld(&bar[XB_XGEN(bx)]) == gen, bar);
            __builtin_amdgcn_fence(__ATOMIC_ACQUIRE, "agent");
            asm volatile("s_waitcnt vmcnt(0)" ::: "memory");
        }
    }
    __syncthreads();
}

#ifndef REP_A
#define REP_A 1
#endif
#ifndef REP_LRU
#define REP_LRU 1
#endif
#ifndef REP_POOL
#define REP_POOL 1
#endif
#ifndef REP_ATT
#define REP_ATT 1
#endif
#ifndef REP_ATTH
#define REP_ATTH 1
#endif
__global__ void __launch_bounds__(512) mega(Args a) {
    extern __shared__ __attribute__((aligned(16))) unsigned char lds_raw[];
    LAS unsigned char* lds = (LAS unsigned char*)lds_raw;
    if (a.inv[31] < 0.f) cg::this_grid().sync();
    volatile LAS unsigned* bst = (volatile LAS unsigned*)(lds + LDS_BYTES - 16);
    if (threadIdx.x < 2) bst[threadIdx.x] = 0u;
    __syncthreads();
    const XcdBarrier xbar = xcd_barrier_post((unsigned*)(a.ws + WS_BAR), bst);
    const int G = gridDim.x, bid = blockIdx.x, NGW = G * 8;
    bf16_t* Z = (bf16_t*)(a.ws + WS_Z); bf16_t* Y = (bf16_t*)(a.ws + WS_Y); bf16_t* XB = (bf16_t*)(a.ws + WS_XB);
    float* ssq = (float*)(a.ws + WS_SSQ);

#ifndef NO_P0
    p0_prologue(a, lds);
#endif
    xcd_barrier(xbar);
    for (int l = 0; l < DEPTH; ++l) {
#define PA_PART(NCOLS, COL0) do { pg8::Gemm g{XB, (const bf16_t*)(a.ws + WS_WIN) + (size_t)(COL0) * DM, M, (NCOLS), DM}; pg8::StaticOrder S; S.init(M, (NCOLS), G, bid); \
            \
          LAS float* rsl = (LAS float*)(lds + 131072); LAS int* pml = (LAS int*)(lds + 131072 + 8192); \
          { int tid_ = threadIdx.x; asm volatile("" : "+v"(tid_)); \
            __syncthreads(); \
            for (int i = 0; i < 8; ++i) { pg8::Unit u; const bool ok = S.next(i, u); if (tid_ == 0) pml[i] = ok ? u.pm : -1; \
                if (ok && tid_ < 256) { const f32x4* sp = (const f32x4*)(ssq + ((size_t)u.pm * 256 + tid_) * 16); const f32x4 s0 = sp[0], s1 = sp[1], s2 = sp[2], s3 = sp[3]; \
                    const float sum = (((s0[0] + s0[1]) + (s0[2] + s0[3])) + ((s1[0] + s1[1]) + (s1[2] + s1[3]))) + (((s2[0] + s2[1]) + (s2[2] + s2[3])) + ((s3[0] + s3[1]) + (s3[2] + s3[3]))); \
                    rsl[i * 256 + tid_] = rsqrtf(sum * (1.0f / 1024.0f) + 1e-6f); } } \
            __syncthreads(); } \
          pg8::EpiZ E{Z + (COL0), rsl, pml, DIN}; \
          pg8::gemm_phase<pg8::EpiZ, pg8::StaticOrder, true, true>(lds, g, S, E); } while (0)
        unsigned* xbr = (unsigned*)(a.ws + WS_BAR) + 3584;
#pragma unroll 1
        for (int part = 0; part < 2; ++part) {
            const int ncols = part ? 512 : 4096, col0 = part ? 4096 : 0;
            if (part == 0 || G != 256 || bid < 128) PA_PART(ncols, col0);
            if (part == (G == 256 ? 0 : 1)) xcd_barrier(xbar);
            if (part == 1 && G == 256 && bid < 128) { __syncthreads(); if (threadIdx.x == 0) (void)__hip_atomic_fetch_add(xbr, 1u, __ATOMIC_RELAXED, __HIP_MEMORY_SCOPE_AGENT); }
        }
        for (int it = 0; ; ++it) { int u;
            if (G == 256) { if (bid >= 128) { u = it < 2 ? 768 + bid + it * 256 : (it == 2 ? 2000 : (it < 7 ? (bid - 128) + (it - 3) * 128 : (it == 7 ? 2001 : 3000))); }
                            else { u = it < 2 ? 512 + bid + it * 128 : (it < 5 ? 768 + bid + (it - 2) * 256 : (it == 5 ? 2000 : (it == 6 ? 2001 : 3000))); } }
            else { u = bid + it * G; if (u >= 1408) { const int over = (u - 1408) / G; u = over == 0 ? 2000 : (over == 1 ? 2001 : 3000); } }
            if (u >= 3000) break;
            __syncthreads();
            if (u >= 2000) {
                int tid_ = threadIdx.x; asm volatile("" : "+v"(tid_)); const int lane = tid_ & 63, wid = tid_ >> 6, gw = bid * 8 + wid;
                LAS float* scr = (LAS float*)(lds + wid * 8448);
                if (u == 2000) transpose_wout(a, l, scr, NGW - 1 - gw, NGW, lane);
                else if (l + 1 < DEPTH) {
                    if (G == 256) { if (tid_ == 0) { unsigned sp = 0; while (__hip_atomic_load(xbr, __ATOMIC_RELAXED, __HIP_MEMORY_SCOPE_AGENT) < 128u * (unsigned)(l + 1)) { __builtin_amdgcn_s_sleep(2); if (++sp > (1u << 22)) break; } } __syncthreads(); }
                    transpose_win(a, l + 1, scr, gw, NGW, lane); }
                continue; }
#ifndef NO_LRU
            if (u < 768) { const int k = u % 6, c = (u / 6) % NCHUNK, b = u / (6 * NCHUNK); for (int rep = 0; rep < REP_LRU; ++rep) { lru_tile(a, l, b, c, k, lds, xbr, (G == 256 && it == (bid >= 128 ? 3 : 0)) ? 128u * (unsigned)(l + 1) : 0u); __syncthreads(); } }
#endif
#ifndef NO_POOL
            if (u >= 768 && u < 1280) { const int v = u - 768; for (int rep = 0; rep < REP_POOL; ++rep) { pool_tile(a, l, v >> 8, (v >> 2) & 63, v & 3, lds); __syncthreads(); } }
#endif
#ifndef NO_ROPE
#ifdef REP_DRY
            if (u >= 1280) {
#pragma unroll 1
              for (int rep = 0; rep < 2; ++rep) rope_unit(a, l, u - 1280, rep == 1 || a.inv[31] < 0.f); }
#else
            if (u >= 1280) rope_unit(a, l, u - 1280);
#endif
#endif
        }
        xcd_barrier(xbar);
#ifndef NOMAX_BOUND
#define NOMAX_BOUND 30.f
#endif
        bool nomax;
        { int tid_ = threadIdx.x; asm volatile("" : "+v"(tid_)); const int ln = tid_ & 63;
          float mq = fmaxf(fabsf(a.in[12][l * 128 + ln]), fabsf(a.in[12][l * 128 + 64 + ln])), mk = fmaxf(fabsf(a.in[13][l * 128 + ln]), fabsf(a.in[13][l * 128 + 64 + ln]));
#pragma unroll
          for (int o = 1; o < 64; o <<= 1) { mq = fmaxf(mq, __shfl_xor(mq, o)); mk = fmaxf(mk, __shfl_xor(mk, o)); }
          nomax = 11.3137085f * 1.02f * mq * mk < NOMAX_BOUND; }
#define ATT_CALL(MODE, ...) do { if (nomax) att::attn_dense_body<att::bf16, MODE, true>(__VA_ARGS__); else att::attn_dense_body<att::bf16, MODE, false>(__VA_ARGS__); } while (0)
        if (G == 256) {
            const int xcd = bid & 7, slot = bid >> 3, grp = xcd >> 1, b = grp >> 1, kvh = grp & 1, base = 48 * (xcd & 1);
            const size_t krow = (size_t)b * SEQL;
            { const int j = base + slot, h = kvh * 3 + (j >> 5), qb = j & 31; const size_t qrow = krow + qb * 256;
              for (int rep = 0; rep < REP_ATT; ++rep) {
              __syncthreads();
              ATT_CALL(0, Z + qrow * DIN + C_Q + h * 128, Z + krow * DIN + C_K + kvh * 128, Z + krow * DIN + C_V + kvh * 128,
                                                 Z + qrow * DIN + C_GATT + h * 128, Y + qrow * DMIX + Y_ATT + h * 128, DMIX, nullptr, SEQL, (char*)lds_raw, a.in[12] + l * 128, (const float*)(a.ws + WS_ROPE), qb * 256); } }
            { const int j = base + 32 + (slot >> 1), half = slot & 1, sidx = xcd * 16 + (slot >> 1), h = kvh * 3 + (j >> 5), qb = j & 31; const size_t qrow = krow + qb * 256, k0 = krow + (size_t)half * (SEQL / 2);
              bf16_t* po = half == 0 ? Y + qrow * DMIX + Y_ATT + h * 128 : (bf16_t*)(a.ws + WS_PART) + (size_t)sidx * 256 * 128;
              for (int rep = 0; rep < REP_ATTH; ++rep) {
              __syncthreads();
              ATT_CALL(1, Z + qrow * DIN + C_Q + h * 128, Z + k0 * DIN + C_K + kvh * 128, Z + k0 * DIN + C_V + kvh * 128,
                                                 nullptr, po, half == 0 ? DMIX : 128, (float*)(a.ws + WS_LSE) + ((size_t)sidx * 2 + half) * 256, SEQL / 2, (char*)lds_raw, a.in[12] + l * 128, (const float*)(a.ws + WS_ROPE), qb * 256); } }
#ifdef REP_DRY
#pragma unroll 1
            for (int rep = 0; rep < 2; ++rep) fixup_unit(a, bid, lds, rep == 1 || a.inv[31] < 0.f);
#else
            fixup_unit(a, bid, lds);
#endif
            xcd_barrier(xbar);
            {
                const int sidx = bid >> 1, rh = bid & 1, sx = sidx >> 4, sgrp = sx >> 1, sb = sgrp >> 1, skvh = sgrp & 1, j = 48 * (sx & 1) + 32 + (sidx & 15), h = skvh * 3 + (j >> 5), qb = j & 31;
                const size_t qrow = (size_t)sb * SEQL + qb * 256 + rh * 128;
                const bf16_t* p2 = (const bf16_t*)(a.ws + WS_PART) + (size_t)sidx * 256 * 128 + (size_t)rh * 128 * 128; const float* lse = (const float*)(a.ws + WS_LSE) + (size_t)sidx * 512 + rh * 128;
                int tid_ = threadIdx.x; asm volatile("" : "+v"(tid_));
                u32x4 o1v[4], o2v[4], gv[4]; float l1v[4], l2v[4];
#pragma unroll
                for (int i = 0; i < 4; ++i) { const int idx = tid_ + i * 512, row = idx >> 4, ck = idx & 15;
                    o1v[i] = *(const u32x4*)(Y + (qrow + row) * DMIX + Y_ATT + h * 128 + ck * 8); o2v[i] = *(const u32x4*)(p2 + row * 128 + ck * 8);
                    gv[i] = *(const u32x4*)(Z + (qrow + row) * DIN + C_GATT + h * 128 + ck * 8); l1v[i] = lse[row]; l2v[i] = lse[256 + row]; }
#pragma unroll
                for (int i = 0; i < 4; ++i) { const int idx = tid_ + i * 512, row = idx >> 4, ck = idx & 15;
                    bf16_t* yp = Y + (qrow + row) * DMIX + Y_ATT + h * 128 + ck * 8;
                    const u32x4 o1 = o1v[i], o2 = o2v[i], g = gv[i];
                    const float l1 = l1v[i], l2 = l2v[i], w1 = __builtin_amdgcn_rcpf(1.f + __expf(l2 - l1)), w2 = 1.f - w1;
                    u32x4 r;
#pragma unroll
                    for (int e = 0; e < 4; ++e) r[e] = pk2((w1 * bflo(o1[e]) + w2 * bflo(o2[e])) * silu_f(bflo(g[e])), (w1 * bfhi(o1[e]) + w2 * bfhi(o2[e])) * silu_f(bfhi(g[e])));
                    *(u32x4*)yp = r; }
            }
        } else {
            for (int ul = bid; ul < 384; ul += G) { const int grp = ul / 96, j = ul % 96, b = grp >> 1, kvh = grp & 1, h = kvh * 3 + (j >> 5), qb = j & 31;
                const size_t qrow = (size_t)b * SEQL + qb * 256, krow = (size_t)b * SEQL;
                __syncthreads();
                ATT_CALL(0, Z + qrow * DIN + C_Q + h * 128, Z + krow * DIN + C_K + kvh * 128, Z + krow * DIN + C_V + kvh * 128,
                                                   Z + qrow * DIN + C_GATT + h * 128, Y + qrow * DMIX + Y_ATT + h * 128, DMIX, nullptr, SEQL, (char*)lds_raw, a.in[12] + l * 128, (const float*)(a.ws + WS_ROPE), qb * 256); }
            for (int f = bid; f < 256; f += G) fixup_unit(a, f, lds);
        }
        xcd_barrier(xbar);
#ifndef NO_D
        { pg8::Gemm g{Y, (const bf16_t*)(a.ws + WS_WOUT), M, DM, DMIX}; pg8::StaticOrder S; S.init(M, DM, G, bid);
          pg8::EpiRes E{l == 0 ? a.in[0] : a.out, a.out, XB, ssq};
#ifdef REP_D
          { pg8::EpiRes E2{l == 0 ? a.in[0] : a.out, (float*)(a.ws + WS_Z), XB, ssq}; pg8::gemm_phase<pg8::EpiRes, pg8::StaticOrder, true, true>(lds, g, S, E2); }
#endif
          pg8::gemm_phase<pg8::EpiRes, pg8::StaticOrder, true, true>(lds, g, S, E); }
#endif
        if (l + 1 < DEPTH) xcd_barrier(xbar);
    }
}

extern "C" void kernel_launch(void* const* d_in, const int* in_sizes, int n_in, void* d_out, int out_size,
                              void* d_ws, size_t ws_size, hipStream_t stream) {
    static int grid_blocks = 0;
    if (!grid_blocks) {
        int dev = 0, cus = 0, per_cu = 0;
        (void)hipGetDevice(&dev);
        (void)hipDeviceGetAttribute(&cus, hipDeviceAttributeMultiprocessorCount, dev);
        (void)hipFuncSetAttribute((const void*)mega, hipFuncAttributeMaxDynamicSharedMemorySize, LDS_BYTES);
        (void)hipOccupancyMaxActiveBlocksPerMultiprocessor(&per_cu, (const void*)mega, 512, LDS_BYTES);
        if (per_cu < 1) per_cu = 1;
        grid_blocks = cus * per_cu;
        if (ws_size < WS_END) fprintf(stderr, "kernel_launch: workspace too small: %zu < %zu\n", ws_size, (size_t)WS_END);
    }
    Args a{};
    for (int i = 0; i < 15 && i < n_in; ++i) a.in[i] = (const float*)d_in[i];
    a.out = (float*)d_out; a.ws = (unsigned char*)d_ws;
    for (int i = 0; i < 32; ++i) a.inv[i] = (float)std::pow(10000.0, -(double)(2 * i) / 64.0);
    (void)hipMemsetAsync((unsigned char*)d_ws + WS_BAR, 0, 16384, stream);
    void* args[] = {&a};
    hipError_t e = hipLaunchCooperativeKernel((const void*)mega, dim3(grid_blocks), dim3(512), args, LDS_BYTES, stream);
    if (e != hipSuccess) fprintf(stderr, "cooperative launch failed: %s (grid %d)\n", hipGetErrorString(e), grid_blocks);
}
```

```cpp
#include <hip/hip_runtime.h>
#include <hip/hip_cooperative_groups.h>
#include <cstdio>
#include <cstdint>
#include <cmath>
namespace cg = cooperative_groups;

namespace pg8 {
#define PG8_LAS __attribute__((address_space(3)))
typedef unsigned short bf16_t;
typedef short bf16x8 __attribute__((ext_vector_type(8)));
typedef float f32x4 __attribute__((ext_vector_type(4)));
typedef unsigned u32x4 __attribute__((ext_vector_type(4)));
constexpr int BM = 256, BK = 64, HALF = 128, HTB = HALF * BK * 2  , STAGE_BYTES = 8 * HTB, NXCD = 8, WGM = 8;

__host__ __device__ __forceinline__ int lds_byte(int r, int c) { const int st = (r >> 4) * 2 + (c >> 5), rr = r & 15, cc = c & 31, ob = rr * 64 + cc * 2; return st * 1024 + (ob ^ (((ob >> 9) & 1) << 5)); }
__host__ __device__ __forceinline__ void stage_rc(int b, int& R, int& C) { const int st = b / 1024, sb = b % 1024, swz = sb ^ (((sb >> 9) & 1) << 5); R = (st >> 1) * 16 + swz / 64; C = (st & 1) * 32 + (swz % 64) / 2; }
__host__ __device__ __forceinline__ int perm32(int rho) { const int n = rho >> 4, i = rho & 15; return 8 * (i >> 2) + 4 * n + (i & 3); }

struct Unit { int pm, pn; };
struct Gemm { const bf16_t* A; const bf16_t* Bt; int M, N, K; };

struct StaticOrder {
    int nM, nN, nwg, G, c;
    __host__ __device__ void init(int M, int N, int G_, int c_) { nM = M / BM; nN = N / BM; nwg = nM * nN; G = G_; c = c_; }
    __host__ __device__ bool next(int i, Unit& u) const {
        const long L = (long)i * G + c; if (L >= nwg) return false;
        int wgid = (int)L; { const int q = nwg / NXCD, r = nwg % NXCD, xcd = wgid % NXCD, off = wgid / NXCD; wgid = (xcd < r ? xcd * (q + 1) : r * (q + 1) + (xcd - r) * q) + off; }
        const int nig = WGM * nN, gid = wgid / nig, fm = gid * WGM, gsz = (nM - fm) < WGM ? (nM - fm) : WGM;
        u.pm = fm + ((wgid % nig) % gsz); u.pn = (wgid % nig) / gsz; return true;
    }
    __device__ __forceinline__ void a_ready(const Unit&) const {}
    __device__ __forceinline__ void done(const Unit&) const {}
};

__device__ __forceinline__ unsigned cvt_pk_bf16(float lo, float hi) { unsigned r; asm volatile("v_cvt_pk_bf16_f32 %0, %1, %2" : "=v"(r) : "v"(lo), "v"(hi)); return r; }

struct EpiZ {
    static constexpr bool PERM = true, AFTER_DRAIN = false;
    bf16_t* Z; const PG8_LAS float* rsl; const PG8_LAS int* pml; int ldz;
    __device__ __forceinline__ void operator()(const f32x4 (&acc)[2][2][4][2], const Unit& u, int wr, int wc, int fr, int fq) const {
        const int row0 = u.pm * BM + wr * 64 + fr, col0 = u.pn * BM + wc * 32 + 8 * fq;
        int slot = 0;
#pragma unroll
        for (int i = 1; i < 8; ++i) slot = (pml[i] == u.pm) ? i : slot;
        const PG8_LAS float* rp = rsl + slot * 256 + wr * 64 + fr;
#pragma unroll
        for (int ai = 0; ai < 2; ++ai)
#pragma unroll
            for (int m = 0; m < 4; ++m) { const int row = row0 + ai * HALF + m * 16;
                const float rs = rp[ai * HALF + m * 16];
                bf16_t* rowp = Z + (size_t)row * ldz + col0;
#pragma unroll
                for (int bj = 0; bj < 2; ++bj) { const f32x4 v0 = acc[ai][bj][m][0] * rs, v1 = acc[ai][bj][m][1] * rs;
                    u32x4 w; w.x = cvt_pk_bf16(v0[0], v0[1]); w.y = cvt_pk_bf16(v0[2], v0[3]); w.z = cvt_pk_bf16(v1[0], v1[1]); w.w = cvt_pk_bf16(v1[2], v1[3]);
                    *(u32x4*)(rowp + bj * HALF) = w; } }
    }
};
struct EpiRes {
    static constexpr bool PERM = true, AFTER_DRAIN = false;
    const float* xin; float* out; bf16_t* XB; float* ssq;
    __device__ __forceinline__ void operator()(const f32x4 (&acc)[2][2][4][2], const Unit& u, int wr, int wc, int fr, int fq) const {
        const int row0 = u.pm * BM + wr * 64 + fr, col0 = u.pn * BM + wc * 32 + 8 * fq;
#pragma unroll
        for (int ai = 0; ai < 2; ++ai) {
            f32x4 xa[4][2][2];
#pragma unroll
            for (int m = 0; m < 4; ++m)
#pragma unroll
                for (int bj = 0; bj < 2; ++bj) { const size_t off = (size_t)(row0 + ai * HALF + m * 16) * 1024 + col0 + bj * HALF;
                    xa[m][bj][0] = *(const f32x4*)(xin + off); xa[m][bj][1] = *(const f32x4*)(xin + off + 4); }
#pragma unroll
            for (int m = 0; m < 4; ++m) { const int row = row0 + ai * HALF + m * 16; float q = 0.f;
#pragma unroll
                for (int bj = 0; bj < 2; ++bj) { const size_t off = (size_t)row * 1024 + col0 + bj * HALF;
                    const f32x4 v0 = acc[ai][bj][m][0] + xa[m][bj][0], v1 = acc[ai][bj][m][1] + xa[m][bj][1];
                    *(f32x4*)(out + off) = v0; *(f32x4*)(out + off + 4) = v1;
                    q += (v0[0] * v0[0] + v0[1] * v0[1]) + (v0[2] * v0[2] + v0[3] * v0[3]) + (v1[0] * v1[0] + v1[1] * v1[1]) + (v1[2] * v1[2] + v1[3] * v1[3]);
                    u32x4 w; w.x = cvt_pk_bf16(v0[0], v0[1]); w.y = cvt_pk_bf16(v0[2], v0[3]); w.z = cvt_pk_bf16(v1[0], v1[1]); w.w = cvt_pk_bf16(v1[2], v1[3]);
                    *(u32x4*)(XB + off) = w; }
                q += __shfl_xor(q, 16); q += __shfl_xor(q, 32);
                if (fq == 0) ssq[(size_t)row * 16 + u.pn * 4 + wc] = q; } }
    }
};

template <class Epi, class Sched, bool ALIGN_EPI = false, bool SP2 = false>
__device__ __forceinline__ void gemm_phase(PG8_LAS unsigned char* lds, const Gemm g, const Sched& S, const Epi& E) {
    int tid_ = threadIdx.x; asm volatile("" : "+v"(tid_));
    const int tid = tid_, wid = __builtin_amdgcn_readfirstlane(tid >> 6), lane = tid & 63, wr = wid >> 2, wc = wid & 3, fr = lane & 15, fq = lane >> 4;
    const int K = g.K, nt = K / BK;
    unsigned voffA[2], voffB[2];
#pragma unroll
    for (int i = 0; i < 2; ++i) { int R, C; stage_rc(tid * 16 + i * 8192, R, C); const int Rb = Epi::PERM ? ((R & ~31) + perm32(R & 31)) : R;
        voffA[i] = (unsigned)(R * K + C) * 2u; voffB[i] = (unsigned)(Rb * K + C) * 2u; }
    const size_t kstep = (size_t)(BK * 2);
    const size_t hstep = (size_t)HALF * K * 2;
    const size_t tstep = 2 * hstep;
    const unsigned ldsw = (unsigned)wid * 1024u;
    const int aoff = lds_byte(wr * 64 + fr, fq * 8), boff = lds_byte(wc * 32 + fr, fq * 8);
#define PG8_SA(b, h) (((b) * 2 + (h)) * HTB)
#define PG8_SB(b, h) ((4 + (b) * 2 + (h)) * HTB)
#define PG8_STAGE(bufoff, gbase, voff) do { _Pragma("unroll") for (int _i = 0; _i < 2; ++_i) \
        __builtin_amdgcn_global_load_lds((const unsigned*)((const char*)(gbase) + (voff)[_i]), (PG8_LAS unsigned*)(lds + (bufoff) + ldsw + _i * 8192), 16, 0, 0); } while (0)
#define PG8_LDA(dst, b, h) do { _Pragma("unroll") for (int m = 0; m < 4; ++m) _Pragma("unroll") for (int k = 0; k < 2; ++k) dst[m][k] = *(const PG8_LAS bf16x8*)(lds + PG8_SA(b, h) + aoff + m * 2048 + k * 1024); } while (0)
#define PG8_LDB(dst, b, h) do { _Pragma("unroll") for (int n = 0; n < 2; ++n) _Pragma("unroll") for (int k = 0; k < 2; ++k) dst[n][k] = *(const PG8_LAS bf16x8*)(lds + PG8_SB(b, h) + boff + n * 2048 + k * 1024); } while (0)
#define PG8_MMA(ai, bj, At, Bt) do { __builtin_amdgcn_s_setprio(1); _Pragma("unroll") for (int m = 0; m < 4; ++m) _Pragma("unroll") for (int n = 0; n < 2; ++n) _Pragma("unroll") for (int k = 0; k < 2; ++k) \
        acc[ai][bj][m][n] = __builtin_amdgcn_mfma_f32_16x16x32_bf16(Bt[n][k], At[m][k], acc[ai][bj][m][n], 0, 0, 0); __builtin_amdgcn_s_setprio(0); } while (0)
#define PG8_WAIT_V(n) asm volatile("s_waitcnt vmcnt(" #n ")" ::: "memory")
#define PG8_WAIT_L(n) asm volatile("s_waitcnt lgkmcnt(" #n ")" ::: "memory")
#define PG8_BAR __builtin_amdgcn_s_barrier()
#define PG8_SCHED __builtin_amdgcn_sched_barrier(0)
    Unit cur, nxt; int ui = 0;
    if (!S.next(0, cur)) return;
    f32x4 acc[2][2][4][2];
#pragma unroll
    for (int a = 0; a < 2; ++a)
#pragma unroll
        for (int b = 0; b < 2; ++b)
#pragma unroll
            for (int m = 0; m < 4; ++m)
#pragma unroll
                for (int n = 0; n < 2; ++n) acc[a][b][m][n] = (f32x4){0.f, 0.f, 0.f, 0.f};
    bf16x8 At[4][2], B0[2][2], B1[2][2];
    const char* cA = (const char*)g.A + (size_t)cur.pm * tstep; const char* cB = (const char*)g.Bt + (size_t)cur.pn * tstep;
    S.a_ready(cur);
    if constexpr (SP2) {
        PG8_STAGE(PG8_SB(0, 0), cB, voffB); PG8_STAGE(PG8_SB(0, 1), cB + hstep, voffB); PG8_STAGE(PG8_SA(0, 0), cA, voffA); PG8_STAGE(PG8_SA(0, 1), cA + hstep, voffA);
        if (wr == 1) PG8_BAR;
        PG8_WAIT_V(2); PG8_BAR;
        PG8_STAGE(PG8_SB(1, 0), cB + kstep, voffB); PG8_STAGE(PG8_SA(1, 0), cA + kstep, voffA); PG8_STAGE(PG8_SB(1, 1), cB + hstep + kstep, voffB);
        PG8_WAIT_V(6); PG8_BAR;
    } else {
        PG8_STAGE(PG8_SB(0, 0), cB, voffB); PG8_STAGE(PG8_SA(0, 0), cA, voffA); PG8_STAGE(PG8_SB(0, 1), cB + hstep, voffB); PG8_STAGE(PG8_SA(0, 1), cA + hstep, voffA);
        if (wr == 1) PG8_BAR;
        PG8_WAIT_V(4); PG8_BAR;
        PG8_STAGE(PG8_SB(1, 0), cB + kstep, voffB); PG8_STAGE(PG8_SA(1, 0), cA + kstep, voffA); PG8_STAGE(PG8_SB(1, 1), cB + hstep + kstep, voffB);
        PG8_WAIT_V(6); PG8_BAR;
    }
    for (;;) {
        const bool has_next = S.next(ui + 1, nxt);
        const char* nA = has_next ? (const char*)g.A + (size_t)nxt.pm * tstep : cA; const char* nB = has_next ? (const char*)g.Bt + (size_t)nxt.pn * tstep : cB;
        for (int t = 0; t < nt; t += 2) {
            const bool last = (t == nt - 2);
            const char* a1 = cA + (size_t)(t + 1) * kstep;
            const char* a2 = last ? nA : cA + (size_t)(t + 2) * kstep; const char* b2 = last ? nB : cB + (size_t)(t + 2) * kstep;
            const char* a3 = a2 + kstep; const char* b3 = b2 + kstep;
            if (last && has_next) S.a_ready(nxt);
            if constexpr (SP2) {
            PG8_LDB(B0, 0, 0); PG8_LDB(B1, 0, 1); PG8_SCHED; PG8_LDA(At, 0, 0); PG8_STAGE(PG8_SA(1, 1), a1 + hstep, voffA);
            PG8_WAIT_V(8); PG8_WAIT_L(0); PG8_BAR; PG8_MMA(0, 0, At, B0); PG8_MMA(0, 1, At, B1); PG8_BAR; PG8_SCHED;
            PG8_LDA(At, 0, 1); PG8_STAGE(PG8_SB(0, 0), b2, voffB); PG8_STAGE(PG8_SB(0, 1), b2 + hstep, voffB); PG8_STAGE(PG8_SA(0, 0), a2, voffA);
            PG8_WAIT_V(8); PG8_WAIT_L(0); PG8_BAR; PG8_MMA(1, 0, At, B0); PG8_MMA(1, 1, At, B1); PG8_BAR; PG8_SCHED;
            PG8_LDB(B0, 1, 0); PG8_LDB(B1, 1, 1); PG8_SCHED; PG8_LDA(At, 1, 0); PG8_STAGE(PG8_SA(0, 1), a2 + hstep, voffA);
            PG8_WAIT_V(8); PG8_WAIT_L(0); PG8_BAR; PG8_MMA(0, 0, At, B0); PG8_MMA(0, 1, At, B1); PG8_BAR; PG8_SCHED;
            PG8_LDA(At, 1, 1); PG8_STAGE(PG8_SB(1, 0), b3, voffB); PG8_STAGE(PG8_SB(1, 1), b3 + hstep, voffB); PG8_STAGE(PG8_SA(1, 0), a3, voffA);
            PG8_WAIT_V(8); PG8_WAIT_L(0); PG8_BAR; PG8_MMA(1, 0, At, B0); PG8_MMA(1, 1, At, B1); PG8_BAR; PG8_SCHED;
            } else {
            PG8_LDB(B0, 0, 0); PG8_SCHED; PG8_LDA(At, 0, 0); PG8_STAGE(PG8_SA(1, 1), a1 + hstep, voffA);
            PG8_WAIT_L(8); PG8_BAR; PG8_WAIT_L(0); PG8_MMA(0, 0, At, B0); PG8_BAR; PG8_SCHED;
            PG8_LDB(B1, 0, 1); PG8_STAGE(PG8_SB(0, 0), b2, voffB);
            PG8_BAR; PG8_WAIT_L(0); PG8_MMA(0, 1, At, B1); PG8_BAR;
            PG8_LDA(At, 0, 1); PG8_STAGE(PG8_SA(0, 0), a2, voffA);
            PG8_BAR; PG8_WAIT_L(0); PG8_MMA(1, 0, At, B0); PG8_BAR; PG8_SCHED;
            PG8_STAGE(PG8_SB(0, 1), b2 + hstep, voffB);
            PG8_WAIT_V(6); PG8_BAR; PG8_MMA(1, 1, At, B1); PG8_BAR;
            PG8_LDB(B0, 1, 0); PG8_SCHED; PG8_LDA(At, 1, 0); PG8_STAGE(PG8_SA(0, 1), a2 + hstep, voffA);
            PG8_WAIT_L(8); PG8_BAR; PG8_WAIT_L(0); PG8_MMA(0, 0, At, B0); PG8_BAR; PG8_SCHED;
            PG8_LDB(B1, 1, 1); PG8_STAGE(PG8_SB(1, 0), b3, voffB);
            PG8_BAR; PG8_WAIT_L(0); PG8_MMA(0, 1, At, B1); PG8_BAR;
            PG8_LDA(At, 1, 1); PG8_STAGE(PG8_SA(1, 0), a3, voffA);
            PG8_BAR; PG8_WAIT_L(0); PG8_MMA(1, 0, At, B0); PG8_BAR; PG8_SCHED;
            PG8_STAGE(PG8_SB(1, 1), b3 + hstep, voffB);
            PG8_WAIT_V(6); PG8_BAR; PG8_MMA(1, 1, At, B1); PG8_BAR;
            }
        }
        if constexpr (ALIGN_EPI) { if (wr == 0) PG8_BAR; }
        if constexpr (!Epi::AFTER_DRAIN) { E(acc, cur, wr, wc, fr, fq); S.done(cur); }
        if (!has_next) break;
#pragma unroll
        for (int a = 0; a < 2; ++a)
#pragma unroll
            for (int b = 0; b < 2; ++b)
#pragma unroll
                for (int m = 0; m < 4; ++m)
#pragma unroll
                    for (int n = 0; n < 2; ++n) acc[a][b][m][n] = (f32x4){0.f, 0.f, 0.f, 0.f};
        cur = nxt; cA = nA; cB = nB; ++ui;
        if constexpr (ALIGN_EPI) { if (wr == 1) PG8_BAR; }
    }
    PG8_WAIT_V(0);
    if constexpr (!ALIGN_EPI) { if (wr == 0) PG8_BAR; }
    PG8_BAR;
    if constexpr (Epi::AFTER_DRAIN) { E.fused(acc, cur, wr, wc, fr, fq, lds, wid, lane); S.done(cur); }
#undef PG8_SA
#undef PG8_SB
#undef PG8_STAGE
#undef PG8_LDA
#undef PG8_LDB
#undef PG8_MMA
#undef PG8_WAIT_V
#undef PG8_WAIT_L
#undef PG8_BAR
#undef PG8_SCHED
}
}
namespace att {
typedef unsigned short bf16;
constexpr int   D = 128, NW = 8, QBLK = 32, KVBLK = 64;
constexpr float SCALE = 0.088388347648318440f;
constexpr float THR = 8.f;
constexpr int SDEPTH = 2;
constexpr int LDQ = 4608, LDK = 4608, LDG = 4608, LDO = 2048;
constexpr size_t SHM_V = KVBLK * D * 2, SHM_K = KVBLK * D * 2, SHM_ATTN = 3 * SHM_V + 3 * SHM_K + NW * 64 * 4;
using bf16x8 = __attribute__((ext_vector_type(8))) short;
using s16x4  = __attribute__((ext_vector_type(4))) short;
using f32x16 = __attribute__((ext_vector_type(16))) float;
using f32x8  = __attribute__((ext_vector_type(8))) float;
using u32x4  = __attribute__((ext_vector_type(4))) unsigned;
#define KSWZ(row, colB) ((row) * 256 + ((colB) ^ (((row) & 7) << 4)))
#undef SBAR
#define SBAR() __builtin_amdgcn_sched_barrier(0)
__device__ __forceinline__ int crow(int r, int hi) { return (r & 3) + 8 * (r >> 2) + 4 * hi; }
__device__ __forceinline__ unsigned cvtpk(float lo, float hi) {
  unsigned r; asm volatile("v_cvt_pk_bf16_f32 %0, %1, %2" : "=v"(r) : "v"(lo), "v"(hi)); return r;
}
template <typename TIn> struct Stage;
template <> struct Stage<bf16>  { using T = bf16x8;
  __device__ static __forceinline__ T ld8(const bf16* p) { return *reinterpret_cast<const bf16x8*>(p); }
  __device__ static __forceinline__ bf16x8 tobf(T x) { return x; } };
template <> struct Stage<float> { using T = f32x8;
  __device__ static __forceinline__ T ld8(const float* p) { return *reinterpret_cast<const f32x8*>(p); }
  __device__ static __forceinline__ bf16x8 tobf(T x) {
    u32x4 w = {cvtpk(x[0], x[1]), cvtpk(x[2], x[3]), cvtpk(x[4], x[5]), cvtpk(x[6], x[7])}; return *reinterpret_cast<bf16x8*>(&w); } };

template <bool NOMAX>
__device__ __forceinline__ void partialSM(f32x16& p0, f32x16& p1, float& m_reg, float& mn, float& alpha) {
  if constexpr (NOMAX) { mn = 0.f; alpha = 1.f; for (int r = 0; r < 16; ++r) p0[r] = __builtin_amdgcn_exp2f(p0[r]); return; }
  constexpr float C = SCALE * 1.4426950408889634f;
  float pmax = p0[0]; for (int r = 1; r < 16; ++r) pmax = fmaxf(pmax, p0[r]); for (int r = 0; r < 16; ++r) pmax = fmaxf(pmax, p1[r]);
  { auto rr = __builtin_amdgcn_permlane32_swap(__float_as_uint(pmax), __float_as_uint(pmax), false, false);
    pmax = fmaxf(__uint_as_float(rr[0]), __uint_as_float(rr[1])); }
  if (__builtin_expect(__all(pmax - m_reg <= THR / SCALE), 1)) { mn = m_reg; alpha = 1.f; }
  else { mn = fmaxf(m_reg, pmax); alpha = __builtin_amdgcn_exp2f((m_reg - mn) * C); m_reg = mn; }
  float mnC = -mn * C;
  for (int r = 0; r < 16; ++r) p0[r] = fmaf(p0[r], C, mnC); for (int r = 0; r < 16; ++r) p1[r] = fmaf(p1[r], C, mnC);
  for (int r = 0; r < 16; ++r) p0[r] = __builtin_amdgcn_exp2f(p0[r]);
}
__device__ __forceinline__ void finishSM(f32x16& p0, f32x16& p1, float alpha, float& l_reg, bf16x8& pa0, bf16x8& pa1, bf16x8& pa2, bf16x8& pa3) {
  for (int r = 0; r < 16; ++r) p1[r] = __builtin_amdgcn_exp2f(p1[r]);
  float ps = 0; for (int r = 0; r < 16; ++r) ps += p0[r]; for (int r = 0; r < 16; ++r) ps += p1[r];
  { auto rr = __builtin_amdgcn_permlane32_swap(__float_as_uint(ps), __float_as_uint(ps), false, false);
    ps = __uint_as_float(rr[0]) + __uint_as_float(rr[1]); }
  l_reg = l_reg * alpha + ps;
#define PK8(P, BASE, OUT) do { u32x4 w = {cvtpk(P[BASE + 0], P[BASE + 1]), cvtpk(P[BASE + 2], P[BASE + 3]), cvtpk(P[BASE + 4], P[BASE + 5]), cvtpk(P[BASE + 6], P[BASE + 7])}; \
    OUT = *reinterpret_cast<bf16x8*>(&w); } while (0)
  PK8(p0, 0, pa0); PK8(p0, 8, pa1); PK8(p1, 0, pa2); PK8(p1, 8, pa3);
#undef PK8
}
__device__ __forceinline__ void qkt(f32x16& p0, f32x16& p1, const bf16* Ks, const bf16x8* qr, int r32, int hi) {
  p0 = f32x16{}; p1 = f32x16{};
  for (int d0 = 0; d0 < 8; ++d0) { int cb = (d0 * 16 + hi * 8) * 2;
    bf16x8 b0 = *reinterpret_cast<const bf16x8*>((const char*)Ks + KSWZ(r32, cb));
    bf16x8 b1 = *reinterpret_cast<const bf16x8*>((const char*)Ks + KSWZ(32 + r32, cb));
    p0 = __builtin_amdgcn_mfma_f32_32x32x16_bf16(b0, qr[d0], p0, 0, 0, 0);
    p1 = __builtin_amdgcn_mfma_f32_32x32x16_bf16(b1, qr[d0], p1, 0, 0, 0); }
}
__device__ __forceinline__ int v_st(int k, int c) { const int kk = (k & ~0xC) | ((k & 4) << 1) | ((k & 8) >> 1); return ((kk >> 3) * 4 + (c >> 5)) * 512 + ((kk & 7) * 32 + (c & 31)) * 2; }
__device__ __forceinline__ int v_rd_base(int lane) { return ((lane & 3) << 3) | (((lane >> 2) & 3) << 6) | (((lane >> 4) & 1) << 5) | (((lane >> 5) & 1) << 11); }
constexpr int v_rd_off(int d0, int ks, int half) { return d0 * 512 + ks * 4096 + half * 256; }
template <int OFF> __device__ __forceinline__ s16x4 tr_read(int vb) {
  s16x4 r; asm volatile("ds_read_b64_tr_b16 %0, %1 offset:%2" : "=&v"(r) : "v"(vb), "i"(OFF) : "memory"); return r;
}
struct VF { s16x4 l0, h0, l1, h1, l2, h2, l3, h3; };
template <int D0> __device__ __forceinline__ void pv_rd(VF& f, int vb) {
  f.l0 = tr_read<v_rd_off(D0, 0, 0)>(vb); f.h0 = tr_read<v_rd_off(D0, 0, 1)>(vb); f.l1 = tr_read<v_rd_off(D0, 1, 0)>(vb); f.h1 = tr_read<v_rd_off(D0, 1, 1)>(vb);
  f.l2 = tr_read<v_rd_off(D0, 2, 0)>(vb); f.h2 = tr_read<v_rd_off(D0, 2, 1)>(vb); f.l3 = tr_read<v_rd_off(D0, 3, 0)>(vb); f.h3 = tr_read<v_rd_off(D0, 3, 1)>(vb);
}
__device__ __forceinline__ void pv_mm(f32x16& od, const VF& f, bf16x8 pa0, bf16x8 pa1, bf16x8 pa2, bf16x8 pa3) {
#define PK(L, H) (bf16x8){L[0], L[1], L[2], L[3], H[0], H[1], H[2], H[3]}
  od = __builtin_amdgcn_mfma_f32_32x32x16_bf16(pa0, PK(f.l0, f.h0), od, 0, 0, 0);
  od = __builtin_amdgcn_mfma_f32_32x32x16_bf16(pa1, PK(f.l1, f.h1), od, 0, 0, 0);
  od = __builtin_amdgcn_mfma_f32_32x32x16_bf16(pa2, PK(f.l2, f.h2), od, 0, 0, 0);
  od = __builtin_amdgcn_mfma_f32_32x32x16_bf16(pa3, PK(f.l3, f.h3), od, 0, 0, 0);
#undef PK
}
__device__ __forceinline__ void pv_d0(f32x16* o, int vb, bf16x8 pa0, bf16x8 pa1, bf16x8 pa2, bf16x8 pa3) {
  VF fa, fb;
  pv_rd<0>(fa, vb);
  pv_rd<1>(fb, vb); asm volatile("s_waitcnt lgkmcnt(8)" ::: "memory"); SBAR(); pv_mm(o[0], fa, pa0, pa1, pa2, pa3); SBAR();
  pv_rd<2>(fa, vb); asm volatile("s_waitcnt lgkmcnt(8)" ::: "memory"); SBAR(); pv_mm(o[1], fb, pa0, pa1, pa2, pa3); SBAR();
  pv_rd<3>(fb, vb); asm volatile("s_waitcnt lgkmcnt(8)" ::: "memory"); SBAR(); pv_mm(o[2], fa, pa0, pa1, pa2, pa3); SBAR();
  asm volatile("s_waitcnt lgkmcnt(0)" ::: "memory"); SBAR(); pv_mm(o[3], fb, pa0, pa1, pa2, pa3);
}

template <typename TQ, int MODE, bool NOMAX>
__device__ __forceinline__ void attn_dense_body(const TQ* __restrict__ Qb, const bf16* __restrict__ Kh, const bf16* __restrict__ Vh,
                                                const bf16* __restrict__ Gb, bf16* __restrict__ Ob, int ldo, float* __restrict__ lse_out, int seq, char* lds,
                                                const float* __restrict__ qnw, const float* __restrict__ rope, int tok0) {
  using St = Stage<bf16>; using SQ = Stage<TQ>;
  int tid_ = threadIdx.x; asm volatile("" : "+v"(tid_));
  const int tid = tid_, wid = tid >> 6, lane = tid & 63, r32 = lane & 31, hi = lane >> 5;
  bf16* V_lds = (bf16*)lds; bf16* K_lds = (bf16*)(lds + 3 * SHM_V);
  float* ws = (float*)(lds + 3 * SHM_V + 3 * SHM_K) + wid * 64; float* li_l = ws; float* al_l = ws + 32;
  float m_reg = -1e30f, l_reg = 0; f32x16 o[4] = {}; bf16x8 qr[8];
  const TQ* Qw = Qb + (long)(wid * QBLK + r32) * LDQ + hi * 8;
#pragma unroll
  for (int d0 = 0; d0 < 8; ++d0) qr[d0] = SQ::tobf(SQ::ld8(Qw + d0 * 16));
  {
    float qf[8][8]; float ss = 0.f;
#pragma unroll
    for (int d0 = 0; d0 < 8; ++d0) { const u32x4 w = *reinterpret_cast<const u32x4*>(&qr[d0]);
#pragma unroll
      for (int e = 0; e < 4; ++e) { qf[d0][2 * e] = __uint_as_float(w[e] << 16); qf[d0][2 * e + 1] = __uint_as_float(w[e] & 0xffff0000u); ss += qf[d0][2 * e] * qf[d0][2 * e] + qf[d0][2 * e + 1] * qf[d0][2 * e + 1]; } }
    { auto rr = __builtin_amdgcn_permlane32_swap(__float_as_uint(ss), __float_as_uint(ss), false, false); ss = __uint_as_float(rr[0]) + __uint_as_float(rr[1]); }
    const float rs = rsqrtf(ss * (1.0f / 128.0f) + 1e-6f) * (NOMAX ? SCALE * 1.4426950408889634f : 1.f);
    const int tpos = tok0 + wid * QBLK + r32;
#pragma unroll
    for (int ax = 0; ax < 2; ++ax) { const int pos = ax ? (tpos & 63) : (tpos >> 6);
#pragma unroll
      for (int h2 = 0; h2 < 2; ++h2) { const int d1 = 4 * ax + h2, d2 = d1 + 2, i0 = h2 * 16 + hi * 8;
        const float* cp = rope + pos * 32 + i0; const float* wp1 = qnw + d1 * 16 + hi * 8; const float* wp2 = qnw + d2 * 16 + hi * 8;
        float o1[8], o2[8];
        typedef float f32x4v __attribute__((ext_vector_type(4)));
        const f32x4v c0 = *reinterpret_cast<const f32x4v*>(cp), c1 = *reinterpret_cast<const f32x4v*>(cp + 4), s0 = *reinterpret_cast<const f32x4v*>(cp + 4096), s1 = *reinterpret_cast<const f32x4v*>(cp + 4100);
        const f32x4v g10 = *reinterpret_cast<const f32x4v*>(wp1), g11 = *reinterpret_cast<const f32x4v*>(wp1 + 4), g20 = *reinterpret_cast<const f32x4v*>(wp2), g21 = *reinterpret_cast<const f32x4v*>(wp2 + 4);
#pragma unroll
        for (int e = 0; e < 8; ++e) { const float w1 = e < 4 ? g10[e & 3] : g11[e & 3], w2 = e < 4 ? g20[e & 3] : g21[e & 3], cs = e < 4 ? c0[e & 3] : c1[e & 3], sn = e < 4 ? s0[e & 3] : s1[e & 3];
          const float a1 = qf[d1][e] * rs * w1, a2 = qf[d2][e] * rs * w2; o1[e] = a1 * cs - a2 * sn; o2[e] = a2 * cs + a1 * sn; }
        u32x4 p1 = {cvtpk(o1[0], o1[1]), cvtpk(o1[2], o1[3]), cvtpk(o1[4], o1[5]), cvtpk(o1[6], o1[7])}, p2 = {cvtpk(o2[0], o2[1]), cvtpk(o2[2], o2[3]), cvtpk(o2[4], o2[5]), cvtpk(o2[6], o2[7])};
        qr[d1] = *reinterpret_cast<bf16x8*>(&p1); qr[d2] = *reinterpret_cast<bf16x8*>(&p2); } } }
  const int sr = tid >> 4, sc = (tid & 15) * 8, vst0 = v_st(sr, sc), vst1 = v_st(32 + sr, sc);
  const int vb0 = (int)(uintptr_t)V_lds + v_rd_base(lane);
  struct { typename St::T vs0, vs1, ks0, ks1; } sr_[1];
#define SLOAD(i, k0) do { sr_[i].vs0 = St::ld8(&Vh[(long)((k0) + sr) * LDK + sc]); sr_[i].vs1 = St::ld8(&Vh[(long)((k0) + 32 + sr) * LDK + sc]); \
    sr_[i].ks0 = St::ld8(&Kh[(long)((k0) + sr) * LDK + sc]); sr_[i].ks1 = St::ld8(&Kh[(long)((k0) + 32 + sr) * LDK + sc]); } while (0)
#define SWRITE(boff, i) do { *(bf16x8*)((char*)V_lds + (boff) + vst0) = St::tobf(sr_[i].vs0);          \
    *(bf16x8*)((char*)V_lds + (boff) + vst1) = St::tobf(sr_[i].vs1); int kc = sc * 2;               \
    *(bf16x8*)((char*)K_lds + (boff) + KSWZ(sr, kc)) = St::tobf(sr_[i].ks0);                       \
    *(bf16x8*)((char*)K_lds + (boff) + KSWZ(32 + sr, kc)) = St::tobf(sr_[i].ks1); } while (0)
#define RESC(a) do { if constexpr (!NOMAX) if (__any((a) < 1.f)) { if (hi == 0) al_l[r32] = (a); asm volatile("s_waitcnt lgkmcnt(0)" ::: "memory"); \
    for (int d = 0; d < 4; ++d) for (int r = 0; r < 16; ++r) o[d][r] *= al_l[crow(r, hi)]; } } while (0)
  f32x16 pA0, pA1, pB0, pB1; float mnA, mnB, alA, alB; bf16x8 pa0, pa1, pa2, pa3; const int NT = seq / KVBLK;
  SLOAD(0, 0); asm volatile("s_waitcnt vmcnt(0)" ::: "memory"); SWRITE(0, 0);
  SLOAD(0, KVBLK); asm volatile("s_waitcnt vmcnt(0)" ::: "memory"); SWRITE((int)SHM_V, 0);
  if (2 < NT) SLOAD(0, 2 * KVBLK);
  __syncthreads();
  qkt(pA0, pA1, K_lds, qr, r32, hi); partialSM<NOMAX>(pA0, pA1, m_reg, mnA, alA);
  int ocur = (int)SHM_V, oprev = 0, onext = 2 * (int)SHM_V;
#define STEP(PC0, PC1, ALC, MNC, PP0, PP1, ALP, T) do { \
    if ((T) + 1 < NT) { asm volatile("s_waitcnt vmcnt(0)" ::: "memory"); SWRITE(onext, 0); } \
    SBAR(); qkt(PC0, PC1, (bf16*)((char*)K_lds + ocur), qr, r32, hi); \
    finishSM(PP0, PP1, ALP, l_reg, pa0, pa1, pa2, pa3); SBAR(); \
    if ((T) + 2 < NT) SLOAD(0, ((T) + 2) * KVBLK); SBAR(); \
    pv_d0(o, vb0 + oprev, pa0, pa1, pa2, pa3); partialSM<NOMAX>(PC0, PC1, m_reg, MNC, ALC); \
    RESC(ALC); __syncthreads(); \
    { const int t_ = oprev; oprev = ocur; ocur = onext; onext = t_; } } while (0)
  for (int t = 1; t + 1 < NT; t += 2) {
    STEP(pB0, pB1, alB, mnB, pA0, pA1, alA, t);
    STEP(pA0, pA1, alA, mnA, pB0, pB1, alB, t + 1);
  }
  STEP(pB0, pB1, alB, mnB, pA0, pA1, alA, NT - 1);
  finishSM(pB0, pB1, alB, l_reg, pa0, pa1, pa2, pa3); SBAR();
  pv_d0(o, vb0 + oprev, pa0, pa1, pa2, pa3);
#undef STEP
  if (hi == 0) li_l[r32] = l_reg; asm volatile("s_waitcnt lgkmcnt(0)" ::: "memory");
  float rli[16];
#pragma unroll
  for (int r = 0; r < 16; ++r) rli[r] = __builtin_amdgcn_rcpf(li_l[crow(r, hi)]);
  bf16* Ow = Ob + (long)(wid * QBLK) * ldo; const bf16* Gw = Gb + (long)(wid * QBLK) * LDG;
  u32x4 gat[8];
  if (MODE == 0) {
#pragma unroll
    for (int it = 0; it < 8; ++it) { const int idx = it * 64 + lane; gat[it] = *reinterpret_cast<const u32x4*>(Gw + (long)(idx >> 4) * LDG + (idx & 15) * 8); } }
  __syncthreads();
  char* ost = lds + wid * 8704;
#pragma unroll
  for (int r = 0; r < 16; ++r) { const int orow = crow(r, hi);
#pragma unroll
    for (int d0 = 0; d0 < 4; ++d0) { const float v = o[d0][r] * rli[r]; *(bf16*)(ost + orow * 272 + (d0 * 32 + r32) * 2) = (bf16)(cvtpk(v, v) & 0xffffu); } }
  asm volatile("s_waitcnt lgkmcnt(0)" ::: "memory");
  if (MODE == 1) { if (hi == 0) lse_out[wid * QBLK + r32] = NOMAX ? __logf(l_reg) : m_reg * SCALE + __logf(l_reg); }
#pragma unroll
  for (int it = 0; it < 8; ++it) { const int idx = it * 64 + lane, row = idx >> 4, ck = idx & 15;
    u32x4 v = *reinterpret_cast<const u32x4*>(ost + row * 272 + ck * 16);
    if (MODE == 0) { const u32x4 g = gat[it];
#pragma unroll
      for (int e = 0; e < 4; ++e) { const float g0 = __uint_as_float(g[e] << 16), g1 = __uint_as_float(g[e] & 0xffff0000u), v0 = __uint_as_float(v[e] << 16), v1 = __uint_as_float(v[e] & 0xffff0000u);
        v[e] = cvtpk(v0 * g0 * __builtin_amdgcn_rcpf(1.f + __expf(-g0)), v1 * g1 * __builtin_amdgcn_rcpf(1.f + __expf(-g1))); } }
    *reinterpret_cast<u32x4*>(Ow + (long)row * ldo + ck * 8) = v; }
#undef SLOAD
#undef SWRITE
#undef RESC
}

}

#define LAS __attribute__((address_space(3)))
typedef unsigned short bf16_t;
typedef short bf16x8 __attribute__((ext_vector_type(8)));
typedef float f32x4 __attribute__((ext_vector_type(4)));
typedef float f32x2 __attribute__((ext_vector_type(2)));
typedef unsigned u32x4 __attribute__((ext_vector_type(4)));
typedef unsigned u32x2 __attribute__((ext_vector_type(2)));

constexpr int NB = 2, SEQL = 8192, M = NB * SEQL, DM = 1024, DIN = 4608, DMIX = 2048, DEPTH = 4;
constexpr int C_UPOOL = 0, C_GPOOL = 512, C_ULRU = 1024, C_GLRU = 1792, C_Q = 2560, C_K = 3328, C_V = 3584, C_GATT = 3840;
constexpr int Y_POOL = 0, Y_LRU = 512, Y_ATT = 1280;
constexpr int NCHUNK = 64;
constexpr size_t WS_Z = 0, WS_Y = WS_Z + (size_t)M * DIN * 2, WS_PF = WS_Y + (size_t)M * DMIX * 2, WS_PB = WS_PF + (size_t)M * 768 * 2,
                 WS_XB = WS_PF  , WS_WIN = WS_PB + (size_t)M * 768 * 2, WS_WOUT = WS_WIN + (size_t)DIN * DM * 2,
                 WS_POOLW = WS_WOUT + (size_t)DM * DMIX * 2, WS_LRUW = WS_POOLW + (size_t)DEPTH * 4 * 16384 * 2, WS_SSQ = WS_LRUW + (size_t)DEPTH * 24 * 16384 * 2,
                 WS_SUMM = WS_SSQ + (size_t)M * 16 * 4, WS_ROPE = WS_SUMM + (size_t)NB * NCHUNK * 2 * 2 * 768 * 4, WS_BAR = WS_ROPE + 2 * 128 * 32 * 4, WS_PART = WS_BAR + 16384  , WS_LSE = WS_PART + (size_t)128 * 256 * 128 * 2  , WS_END = WS_LSE + (size_t)128 * 2 * 256 * 4;
static_assert((size_t)M * DM * 2 <= 2 * (size_t)M * 768 * 2, "XB overlay fits");
static_assert(WS_END <= 301989888ull, "workspace budget (4 x largest input)");
constexpr int LDS_BYTES = 143360;

struct Args { const float* in[15]; float* out; unsigned char* ws; float inv[32]; };

__device__ __forceinline__ float bf2f(unsigned v) { return __uint_as_float(v << 16); }
__device__ __forceinline__ float bflo(unsigned w) { return __uint_as_float(w << 16); }
__device__ __forceinline__ float bfhi(unsigned w) { return __uint_as_float(w & 0xffff0000u); }
__device__ __forceinline__ unsigned pk2(float lo, float hi) { unsigned r; asm volatile("v_cvt_pk_bf16_f32 %0, %1, %2" : "=v"(r) : "v"(lo), "v"(hi)); return r; }
__device__ __forceinline__ float silu_f(float g) { return g * __builtin_amdgcn_rcpf(1.f + __expf(-g)); }
__device__ __forceinline__ float sigmoid_f(float g) { return __builtin_amdgcn_rcpf(1.f + __expf(-g)); }
__device__ __forceinline__ float wave_sum(float v) {
#pragma unroll
    for (int o = 1; o < 64; o <<= 1) v += __shfl_xor(v, o);
    return v;
}
#define LDS_WAIT() asm volatile("s_waitcnt lgkmcnt(0)" ::: "memory")

__device__ __forceinline__ void transpose_item(const float* W, int N, bf16_t* WT, int K, const float* kscale, LAS float* scr, int kb, int nb, int lane) {
    const int k0 = 64 * kb, n0 = 32 * nb;
#pragma unroll
    for (int i = 0; i < 8; ++i) { const int kk = 8 * i + (lane >> 3), n4 = (lane & 7) * 4;
        f32x4 v = *(const f32x4*)(W + (size_t)(k0 + kk) * N + n0 + n4); if (kscale) v = v * kscale[k0 + kk];
        scr[kk * 33 + n4] = v[0]; scr[kk * 33 + n4 + 1] = v[1]; scr[kk * 33 + n4 + 2] = v[2]; scr[kk * 33 + n4 + 3] = v[3]; }
    LDS_WAIT();
    const int c = lane & 7;
#pragma unroll
    for (int j = 0; j < 4; ++j) { const int n = (lane >> 3) + 8 * j; const LAS float* s = scr + (8 * c) * 33 + n;
        u32x4 o; o.x = pk2(s[0 * 33], s[1 * 33]); o.y = pk2(s[2 * 33], s[3 * 33]); o.z = pk2(s[4 * 33], s[5 * 33]); o.w = pk2(s[6 * 33], s[7 * 33]);
        *(u32x4*)(WT + (size_t)(n0 + n) * K + k0 + 8 * c) = o; }
    LDS_WAIT();
}
__device__ __forceinline__ void transpose_win(const Args& a, int l, LAS float* scr, int gw, int NGW, int lane) {
    const float* W = a.in[2] + (size_t)l * DM * DIN; bf16_t* WT = (bf16_t*)(a.ws + WS_WIN); const float* g = a.in[1] + l * DM;
    for (int it = gw; it < (DM / 64) * (DIN / 32); it += NGW) transpose_item(W, DIN, WT, DM, g, scr, it / (DIN / 32), it % (DIN / 32), lane);
}
__device__ __forceinline__ void transpose_wout(const Args& a, int l, LAS float* scr, int gw, int NGW, int lane) {
    const float* W = a.in[14] + (size_t)l * DMIX * DM; bf16_t* WT = (bf16_t*)(a.ws + WS_WOUT);
    for (int it = gw; it < (DMIX / 64) * (DM / 32); it += NGW) transpose_item(W, DM, WT, DMIX, nullptr, scr, it / (DM / 32), it % (DM / 32), lane);
}

__device__ __forceinline__ void sincos_d(double x, float& c, float& s) {
    const double TWO_PI = 6.283185307179586476925287;
    const double r = x - TWO_PI * rint(x / TWO_PI), r2 = r * r;
    double sv = 0.0, cv = 0.0;
#pragma unroll
    for (int k = 14; k >= 0; --k) { sv = sv * r2 / ((2.0 * k + 2.0) * (2.0 * k + 3.0)); sv = 1.0 - sv; cv = cv * r2 / ((2.0 * k + 1.0) * (2.0 * k + 2.0)); cv = 1.0 - cv; }
    s = (float)(sv * r); c = (float)cv;
}
__device__ __forceinline__ void p0_prologue(const Args& a, LAS unsigned char* lds) {
    int tid_ = threadIdx.x; asm volatile("" : "+v"(tid_));
    const int tid = tid_, lane = tid & 63, wid = tid >> 6, G = gridDim.x, gw = blockIdx.x * 8 + wid, NGW = G * 8;
    LAS float* scr = (LAS float*)(lds + wid * 8448);
    transpose_win(a, 0, scr, gw, NGW, lane);
    for (int it = gw; it < (16 + 96) * 8; it += NGW) { const int mat = it >> 3, sub = it & 7; const float* W; bf16_t* WT;
        if (mat < 16) { W = a.in[3] + (size_t)mat * 16384; WT = (bf16_t*)(a.ws + WS_POOLW) + (size_t)mat * 16384; }
        else { const int q = mat - 16, gate = q / 48, r = q % 48, l = r / 12, dir = (r % 12) / 6, blk = r % 6;
            W = a.in[gate ? 9 : 7] + (size_t)r * 16384; WT = (bf16_t*)(a.ws + WS_LRUW) + ((((size_t)l * 6 + blk) * 2 + dir) * 2 + gate) * 16384; }
        transpose_item(W, 128, WT, 128, nullptr, scr, sub >> 2, sub & 3, lane); }
    bf16_t* XB = (bf16_t*)(a.ws + WS_XB); float* ssq = (float*)(a.ws + WS_SSQ);
    for (int m0 = 2 * gw; m0 < M; m0 += 2 * NGW) { f32x4 v[2][4]; float s[2] = {0.f, 0.f};
#pragma unroll
        for (int q = 0; q < 2; ++q) { const f32x4* xr = (const f32x4*)(a.in[0] + (size_t)(m0 + q) * DM) + lane;
#pragma unroll
            for (int j = 0; j < 4; ++j) v[q][j] = xr[64 * j]; }
#pragma unroll
        for (int q = 0; q < 2; ++q) { const int m = m0 + q;
#pragma unroll
            for (int j = 0; j < 4; ++j) s[q] += (v[q][j][0] * v[q][j][0] + v[q][j][1] * v[q][j][1]) + (v[q][j][2] * v[q][j][2] + v[q][j][3] * v[q][j][3]);
            s[q] = wave_sum(s[q]);
            u32x2* o8 = (u32x2*)(XB + (size_t)m * DM) + lane;
#pragma unroll
            for (int j = 0; j < 4; ++j) { u32x2 w; w.x = pk2(v[q][j][0], v[q][j][1]); w.y = pk2(v[q][j][2], v[q][j][3]); o8[64 * j] = w; }
            if (lane < 16) ssq[(size_t)m * 16 + lane] = lane == 0 ? s[q] : 0.f; } }
    float* rope = (float*)(a.ws + WS_ROPE);
    for (int e = blockIdx.x * 512 + tid; e < 128 * 32; e += G * 512) { const float ang = (float)(e >> 5) * a.inv[e & 31]; float c, s; sincos_d((double)ang, c, s); rope[e] = c; rope[4096 + e] = s; }
}

template <int DIR>
__device__ __forceinline__ void lru_scan(f32x4 (&accR)[8], f32x4 (&accI)[8], const LAS bf16_t* At, float vbr, float vbi, float clam, int d, int fr, int fq, int lane, float& Pc_out, float& hc_out) {
    const int qo = DIR ? 3 - fq : fq, src1 = (DIR ? lane + 16 : lane - 16) & 63, src2 = (DIR ? lane + 32 : lane - 32) & 63, lastl = DIR ? fr : 48 + fr;
    float Pc = 1.f, hc = 0.f;
#pragma unroll
    for (int ms = 0; ms < 8; ++ms) { const int m = DIR ? 7 - ms : ms;
        float Pl[4], hl[4]; float P = 1.f, h = 0.f;
#pragma unroll
        for (int s = 0; s < 4; ++s) { const int j = DIR ? 3 - s : s; const int tok = m * 16 + 4 * fq + j;
            const float r = __builtin_amdgcn_rcpf(1.f + __builtin_amdgcn_exp2f(fmaf(accR[m][j], -1.4426950408889634f, vbr)));
            const float ig = __builtin_amdgcn_rcpf(1.f + __builtin_amdgcn_exp2f(fmaf(accI[m][j], -1.4426950408889634f, vbi)));
            const float aa = __builtin_amdgcn_exp2f(clam * r);
            const float om = fmaxf(fmaf(-aa, aa, 1.f), 0.f);
            const float x = bf2f(At[tok * 136 + d]);
            const float inp = __builtin_amdgcn_sqrtf(om) * (ig * x);
            h = aa * h + inp; P = P * aa; Pl[s] = P; hl[s] = h; }
        float Pt = P, ht = h, Pp, hp;
        Pp = __shfl(Pt, src1); hp = __shfl(ht, src1); if (qo >= 1) { ht = ht + Pt * hp; Pt = Pt * Pp; }
        Pp = __shfl(Pt, src2); hp = __shfl(ht, src2); if (qo >= 2) { ht = ht + Pt * hp; Pt = Pt * Pp; }
        float Pe = __shfl(Pt, src1), he = __shfl(ht, src1); if (qo == 0) { Pe = 1.f; he = 0.f; }
        const float h_in = he + Pe * hc, P_in = Pe * Pc;
#pragma unroll
        for (int s = 0; s < 4; ++s) { const int j = DIR ? 3 - s : s; accR[m][j] = hl[s] + Pl[s] * h_in; accI[m][j] = Pl[s] * P_in; }
        hc = __shfl(accR[m][DIR ? 0 : 3], lastl); Pc = __shfl(accI[m][DIR ? 0 : 3], lastl); }
    Pc_out = Pc; hc_out = hc;
}
__device__ __forceinline__ void lru_tile(const Args& a, int l, int b, int c, int k, LAS unsigned char* lds, unsigned* xb_readers = nullptr, unsigned need = 0u) {
    int tid_ = threadIdx.x; asm volatile("" : "+v"(tid_));
    const int tid = tid_, lane = tid & 63, wid = __builtin_amdgcn_readfirstlane(tid >> 6), fr = lane & 15, fq = lane >> 4;
    LAS bf16_t* At = (LAS bf16_t*)lds;
    LAS bf16_t* Ost = (LAS bf16_t*)(lds + 34816);
    const bf16_t* Z = (const bf16_t*)(a.ws + WS_Z); bf16_t* Y = (bf16_t*)(a.ws + WS_Y);
    const int t0 = c * 128; const size_t r0 = (size_t)b * SEQL + t0;
    const int d = wid * 16 + fr;
    bf16x8 wR[2][4], wI[2][4];
#pragma unroll
    for (int dir = 0; dir < 2; ++dir) { const bf16_t* WT = (const bf16_t*)(a.ws + WS_LRUW) + ((((size_t)l * 6 + k) * 2 + dir) * 2) * 16384;
#pragma unroll
        for (int kk = 0; kk < 4; ++kk) { const size_t o = (size_t)d * 128 + kk * 32 + fq * 8; wR[dir][kk] = *(const bf16x8*)(WT + o); wI[dir][kk] = *(const bf16x8*)(WT + 16384 + o); } }
    {
        const int cgi = tid & 15, tg = tid >> 4, ch = k * 128 + cgi * 8;
        const float* cw = a.in[5] + (size_t)l * 4 * 768 + ch; const float* cb = a.in[6] + (size_t)l * 768 + ch;
        float w[4][8], bb[8];
#pragma unroll
        for (int kk = 0; kk < 4; ++kk) { const f32x4 w0 = *(const f32x4*)(cw + kk * 768), w1 = *(const f32x4*)(cw + kk * 768 + 4);
#pragma unroll
            for (int e = 0; e < 4; ++e) { w[kk][e] = w0[e]; w[kk][4 + e] = w1[e]; } }
        { const f32x4 b0 = *(const f32x4*)cb, b1 = *(const f32x4*)(cb + 4);
#pragma unroll
          for (int e = 0; e < 4; ++e) { bb[e] = b0[e]; bb[4 + e] = b1[e]; } }
        float u[7][8];
#pragma unroll
        for (int i = 0; i < 7; ++i) { const int t = t0 + tg * 4 - 1 + i; u32x4 raw = {0u, 0u, 0u, 0u};
            if (t >= 0 && t < SEQL) raw = *(const u32x4*)(Z + ((size_t)b * SEQL + t) * DIN + C_ULRU + ch);
#pragma unroll
            for (int e = 0; e < 4; ++e) { u[i][2 * e] = bflo(raw[e]); u[i][2 * e + 1] = bfhi(raw[e]); } }
#pragma unroll
        for (int i = 0; i < 4; ++i) { float xc[8];
#pragma unroll
            for (int e = 0; e < 8; ++e) xc[e] = bb[e] + u[i][e] * w[0][e] + u[i + 1][e] * w[1][e] + u[i + 2][e] * w[2][e] + u[i + 3][e] * w[3][e];
            u32x4 o; o.x = pk2(xc[0], xc[1]); o.y = pk2(xc[2], xc[3]); o.z = pk2(xc[4], xc[5]); o.w = pk2(xc[6], xc[7]);
            *(LAS u32x4*)(At + (tg * 4 + i) * 136 + cgi * 8) = o; }
    }
    __syncthreads();
    f32x4 hf[8];
#pragma unroll
    for (int dir = 0; dir < 2; ++dir) {
        const float* br = a.in[8] + ((size_t)l * 2 + dir) * 768 + k * 128; const float* bi = a.in[10] + ((size_t)l * 2 + dir) * 768 + k * 128; const float* lam = a.in[11] + ((size_t)l * 2 + dir) * 768 + k * 128;
        float* summ = (float*)(a.ws + WS_SUMM) + ((((size_t)b * NCHUNK + c) * 2 + dir) * 2) * 768 + k * 128;
        f32x4 accR[8], accI[8];
#pragma unroll
        for (int m = 0; m < 8; ++m) { accR[m] = (f32x4){0.f, 0.f, 0.f, 0.f}; accI[m] = (f32x4){0.f, 0.f, 0.f, 0.f}; }
        {
#pragma unroll
          for (int m = 0; m < 8; ++m) { bf16x8 af[4];
#pragma unroll
              for (int kk = 0; kk < 4; ++kk) af[kk] = *(const LAS bf16x8*)(At + (m * 16 + fr) * 136 + kk * 32 + fq * 8);
#pragma unroll
              for (int kk = 0; kk < 4; ++kk) { accR[m] = __builtin_amdgcn_mfma_f32_16x16x32_bf16(af[kk], wR[dir][kk], accR[m], 0, 0, 0);
                                               accI[m] = __builtin_amdgcn_mfma_f32_16x16x32_bf16(af[kk], wI[dir][kk], accI[m], 0, 0, 0); } } }
        const float lm = lam[d], clam = 8.0f * 1.4426950408889634f * (fminf(lm, 0.f) - log1pf(__expf(-fabsf(lm))));
        const float nbr = -1.4426950408889634f * br[d], nbi = -1.4426950408889634f * bi[d];
        float Pc, hc;
        if (dir == 0) lru_scan<0>(accR, accI, At, nbr, nbi, clam, d, fr, fq, lane, Pc, hc);
        else          lru_scan<1>(accR, accI, At, nbr, nbi, clam, d, fr, fq, lane, Pc, hc);
        if (fq == 0) { summ[d] = Pc; summ[768 + d] = hc; }
        LAS bf16_t* Pst = Ost + (1 + dir) * (128 * 136);
#pragma unroll
        for (int m = 0; m < 8; ++m)
#pragma unroll
            for (int j = 0; j < 4; ++j) { const int tok = m * 16 + 4 * fq + j;
                Pst[tok * 136 + d] = (bf16_t)(pk2(accI[m][j], 0.f) & 0xffffu);
                if (dir == 0) hf[m][j] = accR[m][j]; else Ost[tok * 136 + d] = (bf16_t)(pk2(hf[m][j] + accR[m][j], 0.f) & 0xffffu); }
    }
    if (need) { if (tid == 0) { unsigned sp = 0; while (__hip_atomic_load(xb_readers, __ATOMIC_RELAXED, __HIP_MEMORY_SCOPE_AGENT) < need) { __builtin_amdgcn_s_sleep(2); if (++sp > (1u << 22)) break; } } }
    __syncthreads();
    {
        bf16_t* PF = (bf16_t*)(a.ws + WS_PF); bf16_t* PB = (bf16_t*)(a.ws + WS_PB);
#pragma unroll
        for (int i = 0; i < 12; ++i) { const int idx = tid + i * 512, arr = idx >> 11, row = (idx >> 4) & 127, ck = idx & 15;
            const u32x4 v = *(const LAS u32x4*)(Ost + arr * (128 * 136) + row * 136 + ck * 8);
            bf16_t* dst = arr == 0 ? Y + (r0 + row) * DMIX + Y_LRU + k * 128 + ck * 8 : (arr == 1 ? PF : PB) + (r0 + row) * 768 + k * 128 + ck * 8;
            *(u32x4*)dst = v; }
    }
}
__device__ __forceinline__ void pool_tile(const Args& a, int l, int b, int c, int g, LAS unsigned char* lds) {
    int tid_ = threadIdx.x; asm volatile("" : "+v"(tid_));
    const int tid = tid_, lane = tid & 63, wid = tid >> 6, fr = lane & 15, fq = lane >> 4;
    LAS bf16_t* U = (LAS bf16_t*)lds;
    LAS bf16_t* At = (LAS bf16_t*)(lds + 39168);
    LAS bf16_t* Wl = (LAS bf16_t*)(lds + 73984);
    const bf16_t* Z = (const bf16_t*)(a.ws + WS_Z); bf16_t* Y = (bf16_t*)(a.ws + WS_Y);
    const int t0 = c * 128; const size_t r0 = (size_t)b * SEQL + t0; const size_t row = r0 + wid * 16 + fr;
    const bf16_t* WT = (const bf16_t*)(a.ws + WS_POOLW) + ((size_t)l * 4 + g) * 16384;
    u32x4 ur[5], wr_[4]; u32x2 gp[8]; f32x4 sc[8];
#pragma unroll
    for (int i = 0; i < 5; ++i) { const int idx = tid + i * 512, rw = idx >> 4, ck = idx & 15, t = t0 - 8 + rw; ur[i] = (u32x4){0u, 0u, 0u, 0u};
        if (idx < 144 * 16 && t >= 0 && t < SEQL) ur[i] = *(const u32x4*)(Z + ((size_t)b * SEQL + t) * DIN + C_UPOOL + g * 128 + ck * 8); }
#pragma unroll
    for (int i = 0; i < 4; ++i) { const int idx = tid + i * 512; wr_[i] = *(const u32x4*)(WT + (size_t)idx * 8); }
#pragma unroll
    for (int n = 0; n < 8; ++n) { const int d0 = n * 16 + 4 * fq; gp[n] = *(const u32x2*)(Z + row * DIN + C_GPOOL + g * 128 + d0); sc[n] = *(const f32x4*)(a.in[4] + (size_t)l * 512 + g * 128 + d0); }
#pragma unroll
    for (int i = 0; i < 5; ++i) { const int idx = tid + i * 512, rw = idx >> 4, ck = idx & 15; if (idx < 144 * 16) *(LAS u32x4*)(U + rw * 136 + ck * 8) = ur[i]; }
#pragma unroll
    for (int i = 0; i < 4; ++i) { const int idx = tid + i * 512, rw = idx >> 4, ck = idx & 15; *(LAS u32x4*)(Wl + rw * 136 + ck * 8) = wr_[i]; }
    __syncthreads();
    { const int cgi = tid & 15, tg = tid >> 4, half = 1 << g;
#pragma unroll
      for (int i = 0; i < 4; ++i) { const int tl = tg * 4 + i, t = t0 + tl; const int lo = max(t - half, 0), hi = min(t + half, SEQL);
          float s[8];
#pragma unroll
          for (int e = 0; e < 8; ++e) s[e] = 0.f;
          for (int rr = lo; rr < hi; ++rr) { const u32x4 raw = *(const LAS u32x4*)(U + (rr - t0 + 8) * 136 + cgi * 8);
#pragma unroll
              for (int e = 0; e < 4; ++e) { s[2 * e] += bflo(raw[e]); s[2 * e + 1] += bfhi(raw[e]); } }
          const float inv = 1.0f / (float)(hi - lo);
          const u32x4 self = *(const LAS u32x4*)(U + (tl + 8) * 136 + cgi * 8);
          u32x4 o;
#pragma unroll
          for (int e = 0; e < 4; ++e) o[e] = pk2(s[2 * e] * inv - bflo(self[e]), s[2 * e + 1] * inv - bfhi(self[e]));
          *(LAS u32x4*)(At + tl * 136 + cgi * 8) = o; } }
    __syncthreads();
    f32x4 acc[8];
#pragma unroll
    for (int n = 0; n < 8; ++n) acc[n] = (f32x4){0.f, 0.f, 0.f, 0.f};
#pragma unroll
    for (int kk = 0; kk < 4; ++kk) { const bf16x8 af = *(const LAS bf16x8*)(At + (wid * 16 + fr) * 136 + kk * 32 + fq * 8);
#pragma unroll
        for (int n = 0; n < 8; ++n) { const bf16x8 wf = *(const LAS bf16x8*)(Wl + (n * 16 + fr) * 136 + kk * 32 + fq * 8);
            acc[n] = __builtin_amdgcn_mfma_f32_16x16x32_bf16(wf, af, acc[n], 0, 0, 0); } }
#pragma unroll
    for (int n = 0; n < 8; ++n) { const int d0 = n * 16 + 4 * fq;
        u32x2 o; o.x = pk2(acc[n][0] * sc[n][0] * silu_f(bflo(gp[n].x)), acc[n][1] * sc[n][1] * silu_f(bfhi(gp[n].x)));
                 o.y = pk2(acc[n][2] * sc[n][2] * silu_f(bflo(gp[n].y)), acc[n][3] * sc[n][3] * silu_f(bfhi(gp[n].y)));
        *(u32x2*)(Y + row * DMIX + Y_POOL + g * 128 + d0) = o; }
}
__device__ __forceinline__ void rope_unit(const Args& a, int l, int unit, bool wr = true) {
    int tid_ = threadIdx.x; asm volatile("" : "+v"(tid_));
    const int tid = tid_, s16 = tid & 15, ax = s16 >> 3, i0 = (s16 & 7) * 4, kh = (tid >> 4) & 1;
    bf16_t* Z = (bf16_t*)(a.ws + WS_Z); const float* rope = (const float*)(a.ws + WS_ROPE);
    const float* nw = a.in[13] + l * 128 + 64 * ax + i0;
    const f32x4 w1 = *(const f32x4*)nw, w2 = *(const f32x4*)(nw + 32);
    u32x2 r1[8], r2[8]; f32x4 cs[8], sn[8];
#pragma unroll
    for (int it = 0; it < 8; ++it) { const int ri = it * 32 + (tid >> 4), tok = unit * 128 + (ri >> 1);
        const bf16_t* p = Z + (size_t)tok * DIN + C_K + kh * 128 + 64 * ax + i0;
        r1[it] = *(const u32x2*)p; r2[it] = *(const u32x2*)(p + 32);
        const int tpos = tok & (SEQL - 1), pos = ax ? (tpos & 63) : (tpos >> 6);
        cs[it] = *(const f32x4*)(rope + pos * 32 + i0); sn[it] = *(const f32x4*)(rope + 4096 + pos * 32 + i0); }
#pragma unroll
    for (int it = 0; it < 8; ++it) { const int ri = it * 32 + (tid >> 4), tok = unit * 128 + (ri >> 1);
        bf16_t* p = Z + (size_t)tok * DIN + C_K + kh * 128 + 64 * ax + i0;
        float x1[4] = {bflo(r1[it].x), bfhi(r1[it].x), bflo(r1[it].y), bfhi(r1[it].y)}, x2[4] = {bflo(r2[it].x), bfhi(r2[it].x), bflo(r2[it].y), bfhi(r2[it].y)};
        float ss = 0.f;
#pragma unroll
        for (int e = 0; e < 4; ++e) ss += x1[e] * x1[e] + x2[e] * x2[e];
        ss += __shfl_xor(ss, 1); ss += __shfl_xor(ss, 2); ss += __shfl_xor(ss, 4); ss += __shfl_xor(ss, 8);
        const float rs = rsqrtf(ss * (1.0f / 128.0f) + 1e-6f);
        float o1[4], o2[4];
#pragma unroll
        for (int e = 0; e < 4; ++e) { const float a1 = x1[e] * rs * w1[e], a2 = x2[e] * rs * w2[e]; o1[e] = a1 * cs[it][e] - a2 * sn[it][e]; o2[e] = a2 * cs[it][e] + a1 * sn[it][e]; }
        u32x2 q1, q2; q1.x = pk2(o1[0], o1[1]); q1.y = pk2(o1[2], o1[3]); q2.x = pk2(o2[0], o2[1]); q2.y = pk2(o2[2], o2[3]);
        if (wr) { *(u32x2*)p = q1; *(u32x2*)(p + 32) = q2; } }
}
__device__ __forceinline__ void fixup_unit(const Args& a, int f, LAS unsigned char* lds, bool wr = true) {
    int tid_ = threadIdx.x; asm volatile("" : "+v"(tid_));
    const int tid = tid_, b = f >> 7, c = (f >> 1) & 63, hc = f & 1, ch0 = hc * 384;
    LAS float* car = (LAS float*)lds;
    const float* summ = (const float*)(a.ws + WS_SUMM) + (size_t)b * NCHUNK * 4 * 768 + ch0;
    __syncthreads();
    {
        float H[2] = {0.f, 0.f}; int dr[2], ch[2]; bool live[2];
#pragma unroll
        for (int i = 0; i < 2; ++i) { const int q = tid + 512 * i; live[i] = q < 768; dr[i] = q >= 384; ch[i] = q - 384 * dr[i]; }
        const int nsteps = max(c, NCHUNK - 1 - c);
        for (int s0 = 0; s0 < nsteps; s0 += 16) { float P[2][16], h[2][16];
#pragma unroll
            for (int e = 0; e < 16; ++e)
#pragma unroll
                for (int i = 0; i < 2; ++i) { const int st = s0 + e, j = dr[i] ? NCHUNK - 1 - st : st; const bool ok = live[i] && (dr[i] ? (j > c) : (j < c));
                    P[i][e] = 1.f; h[i][e] = 0.f;
                    if (ok) { const float* sp = summ + ((size_t)j * 4 + 2 * dr[i]) * 768 + ch[i]; P[i][e] = sp[0]; h[i][e] = sp[768]; } }
#pragma unroll
            for (int e = 0; e < 16; ++e)
#pragma unroll
                for (int i = 0; i < 2; ++i) H[i] = h[i][e] + P[i][e] * H[i]; }
#pragma unroll
        for (int i = 0; i < 2; ++i) if (live[i]) car[tid + 512 * i] = H[i];
    }
    __syncthreads();
    const bf16_t* Z = (const bf16_t*)(a.ws + WS_Z); bf16_t* Y = (bf16_t*)(a.ws + WS_Y); const bf16_t* PF = (const bf16_t*)(a.ws + WS_PF); const bf16_t* PB = (const bf16_t*)(a.ws + WS_PB);
    const size_t r0 = (size_t)b * SEQL + c * 128;
#pragma unroll
    for (int bt = 0; bt < 2; ++bt) {
        u32x4 hs[6], pf[6], pb[6], gg[6];
#pragma unroll
        for (int i = 0; i < 6; ++i) { const int idx = tid + (bt * 6 + i) * 512, row = idx / 48, ck = idx - row * 48, cc = ch0 + ck * 8; const size_t rr = r0 + row;
            hs[i] = *(const u32x4*)(Y + rr * DMIX + Y_LRU + cc); pf[i] = *(const u32x4*)(PF + rr * 768 + cc); pb[i] = *(const u32x4*)(PB + rr * 768 + cc); gg[i] = *(const u32x4*)(Z + rr * DIN + C_GLRU + cc); }
#pragma unroll
        for (int i = 0; i < 6; ++i) { const int idx = tid + (bt * 6 + i) * 512, row = idx / 48, ck = idx - row * 48, cc = ch0 + ck * 8; const size_t rr = r0 + row;
            const f32x4 f0 = *(const LAS f32x4*)(car + ck * 8), f1 = *(const LAS f32x4*)(car + ck * 8 + 4), b0 = *(const LAS f32x4*)(car + 384 + ck * 8), b1 = *(const LAS f32x4*)(car + 384 + ck * 8 + 4);
            const float cf[8] = {f0[0], f0[1], f0[2], f0[3], f1[0], f1[1], f1[2], f1[3]}, cb[8] = {b0[0], b0[1], b0[2], b0[3], b1[0], b1[1], b1[2], b1[3]};
            u32x4 o;
#pragma unroll
            for (int e = 0; e < 4; ++e) o[e] = pk2((bflo(hs[i][e]) + bflo(pf[i][e]) * cf[2 * e] + bflo(pb[i][e]) * cb[2 * e]) * silu_f(bflo(gg[i][e])),
                                                   (bfhi(hs[i][e]) + bfhi(pf[i][e]) * cf[2 * e + 1] + bfhi(pb[i][e]) * cb[2 * e + 1]) * silu_f(bfhi(gg[i][e])));
            if (wr) *(u32x4*)(Y + rr * DMIX + Y_LRU + cc) = o; } }
}

#define XB_TMO      128
#define XB_XCNT(j)  (256  + 64 * (j))
#define XB_XSUB(j)  (1280 + 64 * (j))
#define XB_XGEN(j)  (2304 + 64 * (j))
#define XB_TOP      3328
#define XB_TOPGEN   3392
#define XCD_BAR_WORDS 3456
#define XB_SPIN_CAP (1u << 18)

__device__ __forceinline__ unsigned xb_ld(unsigned* p)              { return __hip_atomic_load(p, __ATOMIC_RELAXED, __HIP_MEMORY_SCOPE_AGENT); }
__device__ __forceinline__ unsigned xb_add(unsigned* p, unsigned v) { return __hip_atomic_fetch_add(p, v, __ATOMIC_RELAXED, __HIP_MEMORY_SCOPE_AGENT); }
__device__ __forceinline__ unsigned xb_xcc_id() { return (unsigned)__builtin_amdgcn_s_getreg((3 << 11) | 20) & 0xFu; }
#define XB_SPIN(cond, bar) do { unsigned _sp = 0; while (cond) { __builtin_amdgcn_s_sleep(1); \
    if ((++_sp & 255u) == 0u) { if (xb_ld(&(bar)[XB_TMO])) break; if (_sp > XB_SPIN_CAP) { atomicAdd(&(bar)[XB_TMO], 1u); break; } } } } while (0)

struct XcdBarrier {
    unsigned* bar; unsigned x;
    volatile LAS unsigned* st;
};

__device__ __forceinline__ XcdBarrier xcd_barrier_post(unsigned* bar, volatile LAS unsigned* st) {
    XcdBarrier b; b.bar = bar; b.x = xb_xcc_id(); b.st = st;
    if (threadIdx.x == 0) (void)xb_add(&bar[XB_XCNT(b.x)], 1u);
    return b;
}
__device__ __forceinline__ void xcd_barrier_complete(unsigned* bar, unsigned x, unsigned& nloc, unsigned& nx) {
    const unsigned G = gridDim.x * gridDim.y * gridDim.z;
    unsigned sum, cnt, mine, sp = 0u;
    for (;;) {
        sum = 0u; cnt = 0u; mine = 0u;
#pragma unroll
        for (unsigned j = 0; j < 16; ++j) { const unsigned c = xb_ld(&bar[XB_XCNT(j)]); sum += c; cnt += (c > 0u) ? 1u : 0u; mine = (j == x) ? c : mine; }
        if (sum == G) break;
        __builtin_amdgcn_s_sleep(1);
        if ((++sp & 255u) == 0u) { if (xb_ld(&bar[XB_TMO])) break; if (sp > XB_SPIN_CAP) { atomicAdd(&bar[XB_TMO], 1u); break; } }
    }
    nloc = mine > 0u ? mine : 1u; nx = cnt > 0u ? cnt : 1u;
}

__device__ __forceinline__ void xcd_barrier(const XcdBarrier& b) {
    asm volatile("s_waitcnt vmcnt(0)" ::: "memory");
    __syncthreads();
    if (threadIdx.x == 0) {
        unsigned* bar = b.bar; const unsigned bx = xb_xcc_id();
        __builtin_amdgcn_s_waitcnt(0);
        unsigned nloc = b.st[0], nx = b.st[1];
        if (nloc == 0u) { xcd_barrier_complete(bar, bx, nloc, nx); b.st[0] = nloc; b.st[1] = nx; }
        const unsigned old = xb_add(&bar[XB_XSUB(bx)], 1u);
        const unsigned gen = old / nloc;
        if (old + 1u == (gen + 1u) * nloc) {
            __builtin_amdgcn_fence(__ATOMIC_RELEASE, "agent");
            asm volatile("s_waitcnt vmcnt(0)" ::: "memory");
            const unsigned og = xb_add(&bar[XB_TOP], 1u);
            const unsigned tg = og / nx;
            if (og + 1u == (tg + 1u) * nx) xb_add(&bar[XB_TOPGEN], 1u);
            else XB_SPIN(xb_ld(&bar[XB_TOPGEN]) == tg, bar);
            __builtin_amdgcn_fence(__ATOMIC_ACQUIRE, "agent");
            xb_add(&bar[XB_XGEN(bx)], 1u);
            asm volatile("s_waitcnt vmcnt(0)" ::: "memory");
        } else {
            XB_SPIN(xb_ld(&bar[XB_XGEN(bx)]) == gen, bar);
            __builtin_amdgcn_fence(__ATOMIC_ACQUIRE, "agent");
            asm volatile("s_waitcnt vmcnt(0)" ::: "memory");
        }
    }
    __syncthreads();
}

#ifndef REP_A
#define REP_A 1
#endif
#ifndef REP_LRU
#define REP_LRU 1
#endif
#ifndef REP_POOL
#define REP_POOL 1
#endif
#ifndef REP_ATT
#define REP_ATT 1
#endif
#ifndef REP_ATTH
#define REP_ATTH 1
#endif
__global__ void __launch_bounds__(512) mega(Args a) {
    extern __shared__ __attribute__((aligned(16))) unsigned char lds_raw[];
    LAS unsigned char* lds = (LAS unsigned char*)lds_raw;
    if (a.inv[31] < 0.f) cg::this_grid().sync();
    volatile LAS unsigned* bst = (volatile LAS unsigned*)(lds + LDS_BYTES - 16);
    if (threadIdx.x < 2) bst[threadIdx.x] = 0u;
    __syncthreads();
    const XcdBarrier xbar = xcd_barrier_post((unsigned*)(a.ws + WS_BAR), bst);
    const int G = gridDim.x, bid = blockIdx.x, NGW = G * 8;
    bf16_t* Z = (bf16_t*)(a.ws + WS_Z); bf16_t* Y = (bf16_t*)(a.ws + WS_Y); bf16_t* XB = (bf16_t*)(a.ws + WS_XB);
    float* ssq = (float*)(a.ws + WS_SSQ);

#ifndef NO_P0
    p0_prologue(a, lds);
#endif
    xcd_barrier(xbar);
    for (int l = 0; l < DEPTH; ++l) {
#define PA_PART(NCOLS, COL0) do { pg8::Gemm g{XB, (const bf16_t*)(a.ws + WS_WIN) + (size_t)(COL0) * DM, M, (NCOLS), DM}; pg8::StaticOrder S; S.init(M, (NCOLS), G, bid); \
            \
          LAS float* rsl = (LAS float*)(lds + 131072); LAS int* pml = (LAS int*)(lds + 131072 + 8192); \
          { int tid_ = threadIdx.x; asm volatile("" : "+v"(tid_)); \
            __syncthreads(); \
            for (int i = 0; i < 8; ++i) { pg8::Unit u; const bool ok = S.next(i, u); if (tid_ == 0) pml[i] = ok ? u.pm : -1; \
                if (ok && tid_ < 256) { const f32x4* sp = (const f32x4*)(ssq + ((size_t)u.pm * 256 + tid_) * 16); const f32x4 s0 = sp[0], s1 = sp[1], s2 = sp[2], s3 = sp[3]; \
                    const float sum = (((s0[0] + s0[1]) + (s0[2] + s0[3])) + ((s1[0] + s1[1]) + (s1[2] + s1[3]))) + (((s2[0] + s2[1]) + (s2[2] + s2[3])) + ((s3[0] + s3[1]) + (s3[2] + s3[3]))); \
                    rsl[i * 256 + tid_] = rsqrtf(sum * (1.0f / 1024.0f) + 1e-6f); } } \
            __syncthreads(); } \
          pg8::EpiZ E{Z + (COL0), rsl, pml, DIN}; \
          pg8::gemm_phase<pg8::EpiZ, pg8::StaticOrder, true, true>(lds, g, S, E); } while (0)
        unsigned* xbr = (unsigned*)(a.ws + WS_BAR) + 3584;
#pragma unroll 1
        for (int part = 0; part < 2; ++part) {
            const int ncols = part ? 512 : 4096, col0 = part ? 4096 : 0;
            if (part == 0 || G != 256 || bid < 128) PA_PART(ncols, col0);
            if (part == (G == 256 ? 0 : 1)) xcd_barrier(xbar);
            if (part == 1 && G == 256 && bid < 128) { __syncthreads(); if (threadIdx.x == 0) (void)__hip_atomic_fetch_add(xbr, 1u, __ATOMIC_RELAXED, __HIP_MEMORY_SCOPE_AGENT); }
        }
        for (int it = 0; ; ++it) { int u;
            if (G == 256) { if (bid >= 128) { u = it < 2 ? 768 + bid + it * 256 : (it == 2 ? 2000 : (it < 7 ? (bid - 128) + (it - 3) * 128 : (it == 7 ? 2001 : 3000))); }
                            else { u = it < 2 ? 512 + bid + it * 128 : (it < 5 ? 768 + bid + (it - 2) * 256 : (it == 5 ? 2000 : (it == 6 ? 2001 : 3000))); } }
            else { u = bid + it * G; if (u >= 1408) { const int over = (u - 1408) / G; u = over == 0 ? 2000 : (over == 1 ? 2001 : 3000); } }
            if (u >= 3000) break;
            __syncthreads();
            if (u >= 2000) {
                int tid_ = threadIdx.x; asm volatile("" : "+v"(tid_)); const int lane = tid_ & 63, wid = tid_ >> 6, gw = bid * 8 + wid;
                LAS float* scr = (LAS float*)(lds + wid * 8448);
                if (u == 2000) transpose_wout(a, l, scr, NGW - 1 - gw, NGW, lane);
                else if (l + 1 < DEPTH) {
                    if (G == 256) { if (tid_ == 0) { unsigned sp = 0; while (__hip_atomic_load(xbr, __ATOMIC_RELAXED, __HIP_MEMORY_SCOPE_AGENT) < 128u * (unsigned)(l + 1)) { __builtin_amdgcn_s_sleep(2); if (++sp > (1u << 22)) break; } } __syncthreads(); }
                    transpose_win(a, l + 1, scr, gw, NGW, lane); }
                continue; }
#ifndef NO_LRU
            if (u < 768) { const int k = u % 6, c = (u / 6) % NCHUNK, b = u / (6 * NCHUNK); for (int rep = 0; rep < REP_LRU; ++rep) { lru_tile(a, l, b, c, k, lds, xbr, (G == 256 && it == (bid >= 128 ? 3 : 0)) ? 128u * (unsigned)(l + 1) : 0u); __syncthreads(); } }
#endif
#ifndef NO_POOL
            if (u >= 768 && u < 1280) { const int v = u - 768; for (int rep = 0; rep < REP_POOL; ++rep) { pool_tile(a, l, v >> 8, (v >> 2) & 63, v & 3, lds); __syncthreads(); } }
#endif
#ifndef NO_ROPE
#ifdef REP_DRY
            if (u >= 1280) {
#pragma unroll 1
              for (int rep = 0; rep < 2; ++rep) rope_unit(a, l, u - 1280, rep == 1 || a.inv[31] < 0.f); }
#else
            if (u >= 1280) rope_unit(a, l, u - 1280);
#endif
#endif
        }
        xcd_barrier(xbar);
#ifndef NOMAX_BOUND
#define NOMAX_BOUND 30.f
#endif
        bool nomax;
        { int tid_ = threadIdx.x; asm volatile("" : "+v"(tid_)); const int ln = tid_ & 63;
          float mq = fmaxf(fabsf(a.in[12][l * 128 + ln]), fabsf(a.in[12][l * 128 + 64 + ln])), mk = fmaxf(fabsf(a.in[13][l * 128 + ln]), fabsf(a.in[13][l * 128 + 64 + ln]));
#pragma unroll
          for (int o = 1; o < 64; o <<= 1) { mq = fmaxf(mq, __shfl_xor(mq, o)); mk = fmaxf(mk, __shfl_xor(mk, o)); }
          nomax = 11.3137085f * 1.02f * mq * mk < NOMAX_BOUND; }
#define ATT_CALL(MODE, ...) do { if (nomax) att::attn_dense_body<att::bf16, MODE, true>(__VA_ARGS__); else att::attn_dense_body<att::bf16, MODE, false>(__VA_ARGS__); } while (0)
        if (G == 256) {
            const int xcd = bid & 7, slot = bid >> 3, grp = xcd >> 1, b = grp >> 1, kvh = grp & 1, base = 48 * (xcd & 1);
            const size_t krow = (size_t)b * SEQL;
            { const int j = base + slot, h = kvh * 3 + (j >> 5), qb = j & 31; const size_t qrow = krow + qb * 256;
              for (int rep = 0; rep < REP_ATT; ++rep) {
              __syncthreads();
              ATT_CALL(0, Z + qrow * DIN + C_Q + h * 128, Z + krow * DIN + C_K + kvh * 128, Z + krow * DIN + C_V + kvh * 128,
                                                 Z + qrow * DIN + C_GATT + h * 128, Y + qrow * DMIX + Y_ATT + h * 128, DMIX, nullptr, SEQL, (char*)lds_raw, a.in[12] + l * 128, (const float*)(a.ws + WS_ROPE), qb * 256); } }
            { const int j = base + 32 + (slot >> 1), half = slot & 1, sidx = xcd * 16 + (slot >> 1), h = kvh * 3 + (j >> 5), qb = j & 31; const size_t qrow = krow + qb * 256, k0 = krow + (size_t)half * (SEQL / 2);
              bf16_t* po = half == 0 ? Y + qrow * DMIX + Y_ATT + h * 128 : (bf16_t*)(a.ws + WS_PART) + (size_t)sidx * 256 * 128;
              for (int rep = 0; rep < REP_ATTH; ++rep) {
              __syncthreads();
              ATT_CALL(1, Z + qrow * DIN + C_Q + h * 128, Z + k0 * DIN + C_K + kvh * 128, Z + k0 * DIN + C_V + kvh * 128,
                                                 nullptr, po, half == 0 ? DMIX : 128, (float*)(a.ws + WS_LSE) + ((size_t)sidx * 2 + half) * 256, SEQL / 2, (char*)lds_raw, a.in[12] + l * 128, (const float*)(a.ws + WS_ROPE), qb * 256); } }
#ifdef REP_DRY
#pragma unroll 1
            for (int rep = 0; rep < 2; ++rep) fixup_unit(a, bid, lds, rep == 1 || a.inv[31] < 0.f);
#else
            fixup_unit(a, bid, lds);
#endif
            xcd_barrier(xbar);
            {
                const int sidx = bid >> 1, rh = bid & 1, sx = sidx >> 4, sgrp = sx >> 1, sb = sgrp >> 1, skvh = sgrp & 1, j = 48 * (sx & 1) + 32 + (sidx & 15), h = skvh * 3 + (j >> 5), qb = j & 31;
                const size_t qrow = (size_t)sb * SEQL + qb * 256 + rh * 128;
                const bf16_t* p2 = (const bf16_t*)(a.ws + WS_PART) + (size_t)sidx * 256 * 128 + (size_t)rh * 128 * 128; const float* lse = (const float*)(a.ws + WS_LSE) + (size_t)sidx * 512 + rh * 128;
                int tid_ = threadIdx.x; asm volatile("" : "+v"(tid_));
                u32x4 o1v[4], o2v[4], gv[4]; float l1v[4], l2v[4];
#pragma unroll
                for (int i = 0; i < 4; ++i) { const int idx = tid_ + i * 512, row = idx >> 4, ck = idx & 15;
                    o1v[i] = *(const u32x4*)(Y + (qrow + row) * DMIX + Y_ATT + h * 128 + ck * 8); o2v[i] = *(const u32x4*)(p2 + row * 128 + ck * 8);
                    gv[i] = *(const u32x4*)(Z + (qrow + row) * DIN + C_GATT + h * 128 + ck * 8); l1v[i] = lse[row]; l2v[i] = lse[256 + row]; }
#pragma unroll
                for (int i = 0; i < 4; ++i) { const int idx = tid_ + i * 512, row = idx >> 4, ck = idx & 15;
                    bf16_t* yp = Y + (qrow + row) * DMIX + Y_ATT + h * 128 + ck * 8;
                    const u32x4 o1 = o1v[i], o2 = o2v[i], g = gv[i];
                    const float l1 = l1v[i], l2 = l2v[i], w1 = __builtin_amdgcn_rcpf(1.f + __expf(l2 - l1)), w2 = 1.f - w1;
                    u32x4 r;
#pragma unroll
                    for (int e = 0; e < 4; ++e) r[e] = pk2((w1 * bflo(o1[e]) + w2 * bflo(o2[e])) * silu_f(bflo(g[e])), (w1 * bfhi(o1[e]) + w2 * bfhi(o2[e])) * silu_f(bfhi(g[e])));
                    *(u32x4*)yp = r; }
            }
        } else {
            for (int ul = bid; ul < 384; ul += G) { const int grp = ul / 96, j = ul % 96, b = grp >> 1, kvh = grp & 1, h = kvh * 3 + (j >> 5), qb = j & 31;
                const size_t qrow = (size_t)b * SEQL + qb * 256, krow = (size_t)b * SEQL;
                __syncthreads();
                ATT_CALL(0, Z + qrow * DIN + C_Q + h * 128, Z + krow * DIN + C_K + kvh * 128, Z + krow * DIN + C_V + kvh * 128,
                                                   Z + qrow * DIN + C_GATT + h * 128, Y + qrow * DMIX + Y_ATT + h * 128, DMIX, nullptr, SEQL, (char*)lds_raw, a.in[12] + l * 128, (const float*)(a.ws + WS_ROPE), qb * 256); }
            for (int f = bid; f < 256; f += G) fixup_unit(a, f, lds);
        }
        xcd_barrier(xbar);
#ifndef NO_D
        { pg8::Gemm g{Y, (const bf16_t*)(a.ws + WS_WOUT), M, DM, DMIX}; pg8::StaticOrder S; S.init(M, DM, G, bid);
          pg8::EpiRes E{l == 0 ? a.in[0] : a.out, a.out, XB, ssq};
#ifdef REP_D
          { pg8::EpiRes E2{l == 0 ? a.in[0] : a.out, (float*)(a.ws + WS_Z), XB, ssq}; pg8::gemm_phase<pg8::EpiRes, pg8::StaticOrder, true, true>(lds, g, S, E2); }
#endif
          pg8::gemm_phase<pg8::EpiRes, pg8::StaticOrder, true, true>(lds, g, S, E); }
#endif
        if (l + 1 < DEPTH) xcd_barrier(xbar);
    }
}

extern "C" void kernel_launch(void* const* d_in, const int* in_sizes, int n_in, void* d_out, int out_size,
                              void* d_ws, size_t ws_size, hipStream_t stream) {
    static int grid_blocks = 0;
    if (!grid_blocks) {
        int dev = 0, cus = 0, per_cu = 0;
        (void)hipGetDevice(&dev);
        (void)hipDeviceGetAttribute(&cus, hipDeviceAttributeMultiprocessorCount, dev);
        (void)hipFuncSetAttribute((const void*)mega, hipFuncAttributeMaxDynamicSharedMemorySize, LDS_BYTES);
        (void)hipOccupancyMaxActiveBlocksPerMultiprocessor(&per_cu, (const void*)mega, 512, LDS_BYTES);
        if (per_cu < 1) per_cu = 1;
        grid_blocks = cus * per_cu;
        if (ws_size < WS_END) fprintf(stderr, "kernel_launch: workspace too small: %zu < %zu\n", ws_size, (size_t)WS_END);
    }
    Args a{};
    for (int i = 0; i < 15 && i < n_in; ++i) a.in[i] = (const float*)d_in[i];
    a.out = (float*)d_out; a.ws = (unsigned char*)d_ws;
    for (int i = 0; i < 32; ++i) a.inv[i] = (float)std::pow(10000.0, -(double)(2 * i) / 64.0);
    (void)hipMemsetAsync((unsigned char*)d_ws + WS_BAR, 0, 16384, stream);
    void* args[] = {&a};
    hipError_t e = hipLaunchCooperativeKernel((const void*)mega, dim3(grid_blocks), dim3(512), args, LDS_BYTES, stream);
    if (e != hipSuccess) fprintf(stderr, "cooperative launch failed: %s (grid %d)\n", hipGetErrorString(e), grid_blocks);
}
```
